# Optimizing an MI355X kernel written in HIP

```python
import jax, jax.numpy as jnp
from jax import lax
import numpy as np

D_MODEL = 1024
BATCH = 1
SEQ = 16384
DEPTH = 1

GRID_W = 64
CTX_LEN = 256
N_HEADS = 8
HEAD_DIM = 64
ATT_W = N_HEADS * HEAD_DIM
WIN_H = 8
WIN_W = 16
POOL_WINDOWS = (2, 4, 8, 16)
POOL_GROUPS = 4
POOL_DIM = 128
POOL_W = POOL_GROUPS * POOL_DIM
PROJ_W = 3 * ATT_W + POOL_W + 2 * D_MODEL
SPLIT_POINTS = (ATT_W, 2 * ATT_W, 3 * ATT_W, 3 * ATT_W + POOL_W, 3 * ATT_W + POOL_W + D_MODEL)
N_GROUPS = 4
EXPERTS_PER_GROUP = 8
N_EXPERTS = N_GROUPS * EXPERTS_PER_GROUP
TOP_K_EXPERT = 2
D_EXPERT = 512
N_MOD = 6
DEEPNORM_ALPHA = (2.0 * DEPTH) ** 0.25
DEEPNORM_BETA = (8.0 * DEPTH) ** -0.25
LN_EPS = 1e-5
NEG_INF = -1e30

kernel_name = "hybrid_natten_pool_hmoe_dit"


def layer_norm(x, g, b):
    xf = x.astype(jnp.float32)
    mu = jnp.mean(xf, axis=-1, keepdims=True)
    var = jnp.mean(jnp.square(xf - mu), axis=-1, keepdims=True)
    y = (xf - mu) * lax.rsqrt(var + LN_EPS)
    return (y * g.astype(jnp.float32) + b.astype(jnp.float32)).astype(x.dtype)


def adaln_params(cond, w_mod, b_mod):
    mod = (jax.nn.silu(cond) @ w_mod + b_mod)[:, None, :]
    return jnp.split(mod, N_MOD, axis=-1)


def modulate(h, shift, scale):
    return h * (1.0 + scale) + shift


def split_heads(t):
    B, L, _ = t.shape
    return t.reshape(B, L, N_HEADS, HEAD_DIM)


def neighbourhood_attention(q, k, v, k_ctx, v_ctx, rpb):
    B, L, H, Dh = q.shape
    rows = L // GRID_W
    kh = min(WIN_H, rows)
    n_loc = kh * GRID_W
    scale = Dh ** -0.5
    qg = q.reshape(B, rows, GRID_W, H, Dh)
    kg = k.reshape(B, rows, GRID_W, H, Dh)
    vg = v.reshape(B, rows, GRID_W, H, Dh)
    r = jnp.arange(rows, dtype=jnp.int32)
    row_start = jnp.clip(r - kh // 2, 0, rows - kh)
    col = jnp.arange(GRID_W, dtype=jnp.int32)
    col_start = jnp.clip(col - WIN_W // 2, 0, GRID_W - WIN_W)
    col_mask = (col[None, :] >= col_start[:, None]) & (col[None, :] < col_start[:, None] + WIN_W)
    col_off = jnp.clip(col[None, :] - col[:, None], 1 - WIN_W, WIN_W - 1) + (WIN_W - 1)
    rpb32 = rpb.astype(jnp.float32)

    def row_block(args):
        q_row, rs, rq = args
        kb = lax.dynamic_slice_in_dim(kg, rs, kh, axis=1)
        vb = lax.dynamic_slice_in_dim(vg, rs, kh, axis=1)
        row_off = rs + jnp.arange(kh, dtype=jnp.int32) - rq + (WIN_H - 1)
        bias = rpb32[:, row_off[None, :, None], col_off[:, None, :]]
        s_loc = jnp.einsum('bqhd,bikhd->bhqik', q_row, kb,
                           preferred_element_type=jnp.float32) * scale + bias[None]
        s_loc = jnp.where(col_mask[:, None, :], s_loc, NEG_INF).reshape(B, H, GRID_W, n_loc)
        s_ctx = jnp.einsum('bqhd,bchd->bhqc', q_row, k_ctx,
                           preferred_element_type=jnp.float32) * scale
        p = jax.nn.softmax(jnp.concatenate([s_loc, s_ctx], axis=-1), axis=-1).astype(v.dtype)
        o = (jnp.einsum('bhqk,bkhd->bqhd', p[..., :n_loc], vb.reshape(B, n_loc, H, Dh))
             + jnp.einsum('bhqc,bchd->bqhd', p[..., n_loc:], v_ctx))
        return o

    out = lax.map(row_block, (jnp.moveaxis(qg, 1, 0), row_start, r))
    return jnp.moveaxis(out, 0, 1).reshape(B, L, H * Dh)


def context_attention(q, k, v):
    B, C, H, Dh = q.shape
    s = jnp.einsum('bqhd,bkhd->bhqk', q, k, preferred_element_type=jnp.float32) * (Dh ** -0.5)
    p = jax.nn.softmax(s, axis=-1).astype(v.dtype)
    return jnp.einsum('bhqk,bkhd->bqhd', p, v).reshape(B, C, H * Dh)


def multiscale_pool(u, w_grp, layer_scale):
    B, L, _ = u.shape
    ug = u.reshape(B, L, POOL_GROUPS, POOL_DIM)
    ugf = ug.astype(jnp.float32)
    csum = jnp.concatenate([jnp.zeros((B, 1, POOL_GROUPS, POOL_DIM), jnp.float32),
                            jnp.cumsum(ugf, axis=1)], axis=1)
    win = jnp.asarray(POOL_WINDOWS, dtype=jnp.int32)
    t = jnp.arange(L, dtype=jnp.int32)[:, None]
    lo = jnp.clip(t - win // 2, 0, L)
    hi = jnp.clip(t + win - win // 2, 0, L)
    grp = jnp.arange(POOL_GROUPS, dtype=jnp.int32)[None, :]
    mean = (csum[:, hi, grp] - csum[:, lo, grp]) / (hi - lo).astype(jnp.float32)[None, :, :, None]
    pooled = (mean - ugf).astype(u.dtype)
    y = jnp.einsum('blgi,gio->blgo', pooled, w_grp).reshape(B, L, POOL_W)
    return y * layer_scale


def merge_branches(y_attn, y_pool, gate_a, gate_b, w_attn_proj, w_pool_proj, w_out):
    ya = y_attn @ w_attn_proj
    yp = y_pool @ w_pool_proj
    return (jax.nn.sigmoid(gate_a) * ya + jax.nn.sigmoid(gate_b) * yp) @ w_out


def hierarchical_moe(h, w_rg, b_rg, w_re, b_re, w_gate, w_up, w_down):
    B, L, D = h.shape
    T = B * L
    ht = h.reshape(T, D)
    p_group = jax.nn.softmax((ht @ w_rg).astype(jnp.float32) + b_rg.astype(jnp.float32), axis=-1)
    p_top_group, group_idx = lax.top_k(p_group, 1)
    logit_e = ((ht @ w_re).astype(jnp.float32) + b_re.astype(jnp.float32)).reshape(T, N_GROUPS, EXPERTS_PER_GROUP)
    logit_sel = logit_e[jnp.arange(T), group_idx[:, 0]]
    p_e = jax.nn.softmax(logit_sel, axis=-1)
    p_top_e, e_idx = lax.top_k(p_e, TOP_K_EXPERT)
    p_top_e = p_top_e / jnp.sum(p_top_e, axis=-1, keepdims=True)
    combine = p_top_group * p_top_e
    expert_id = group_idx * EXPERTS_PER_GROUP + e_idx
    gates = jnp.sum(jax.nn.one_hot(expert_id, N_EXPERTS, dtype=jnp.float32) * combine[..., None],
                    axis=1).astype(h.dtype)
    y = jnp.zeros((T, D), jnp.float32)
    for g in range(N_GROUPS):
        sl = slice(g * EXPERTS_PER_GROUP, (g + 1) * EXPERTS_PER_GROUP)
        a = jnp.einsum('td,edf->tef', ht, w_gate[sl])
        u = jnp.einsum('td,edf->tef', ht, w_up[sl])
        act = jax.nn.silu(a) * u * gates[:, sl, None]
        y = y + jnp.einsum('tef,efd->td', act, w_down[sl], preferred_element_type=jnp.float32)
    return y.astype(h.dtype).reshape(B, L, D)


def setup_inputs(seed: int = 0) -> dict:
    key = jax.random.key(seed)
    ks = jax.random.split(key, 32)
    f32 = jnp.float32

    def nrm(k, shape, fan_in, gain=1.0):
        return jax.random.normal(k, shape, f32) * (gain * fan_in ** -0.5)

    def small(k, shape, s):
        return jax.random.normal(k, shape, f32) * s

    D = D_MODEL
    return {
        "x": jax.random.normal(ks[0], (BATCH, SEQ, D), f32),
        "c": jax.random.normal(ks[1], (BATCH, D), f32),
        "ctx": jax.random.normal(ks[2], (BATCH, CTX_LEN, D), f32),
        "c_ctx": jax.random.normal(ks[3], (D,), f32),
        "ln_in_g": 1.0 + small(ks[4], (D,), 0.02),
        "ln_in_b": small(ks[5], (D,), 0.02),
        "w_mod": nrm(ks[6], (DEPTH, D, N_MOD * D), D, 0.2),
        "b_mod": small(ks[7], (DEPTH, N_MOD * D), 0.02),
        "w_in": nrm(ks[8], (DEPTH, D, PROJ_W), D),
        "rpb": small(ks[9], (DEPTH, N_HEADS, 2 * WIN_H - 1, 2 * WIN_W - 1), 0.5),
        "w_pool_grp": nrm(ks[10], (DEPTH, POOL_GROUPS, POOL_DIM, POOL_DIM), POOL_DIM),
        "pool_scale": 1.0 + small(ks[11], (DEPTH, POOL_W), 0.02),
        "w_attn_proj": nrm(ks[12], (DEPTH, ATT_W, D), ATT_W),
        "w_pool_proj": nrm(ks[13], (DEPTH, POOL_W, D), POOL_W),
        "w_out": nrm(ks[14], (DEPTH, D, D), D, DEEPNORM_BETA),
        "ln1_g": 1.0 + small(ks[15], (DEPTH, D), 0.02),
        "ln1_b": small(ks[16], (DEPTH, D), 0.02),
        "w_router_group": nrm(ks[17], (DEPTH, D, N_GROUPS), D),
        "b_router_group": small(ks[18], (DEPTH, N_GROUPS), 0.01),
        "w_router_expert": nrm(ks[19], (DEPTH, D, N_EXPERTS), D),
        "b_router_expert": small(ks[20], (DEPTH, N_EXPERTS), 0.01),
        "w_expert_gate": nrm(ks[21], (DEPTH, N_EXPERTS, D, D_EXPERT), D),
        "w_expert_up": nrm(ks[22], (DEPTH, N_EXPERTS, D, D_EXPERT), D),
        "w_expert_down": nrm(ks[23], (DEPTH, N_EXPERTS, D_EXPERT, D), D_EXPERT, DEEPNORM_BETA),
        "ln2_g": 1.0 + small(ks[24], (DEPTH, D), 0.02),
        "ln2_b": small(ks[25], (DEPTH, D), 0.02),
    }


def reference(x, c, ctx, c_ctx, ln_in_g, ln_in_b, w_mod, b_mod, w_in, rpb, w_pool_grp, pool_scale,
              w_attn_proj, w_pool_proj, w_out, ln1_g, ln1_b, w_router_group, b_router_group,
              w_router_expert, b_router_expert, w_expert_gate, w_expert_up, w_expert_down, ln2_g, ln2_b):
    alpha = DEEPNORM_ALPHA
    h = layer_norm(x, ln_in_g, ln_in_b)
    hc = layer_norm(ctx, ln_in_g, ln_in_b)

    for layer in range(DEPTH):
        last = layer == DEPTH - 1
        sh1, sc1, g1, sh2, sc2, g2 = adaln_params(c, w_mod[layer], b_mod[layer])
        csh1, csc1, cg1, csh2, csc2, cg2 = adaln_params(c_ctx[None, :], w_mod[layer], b_mod[layer])
        wl = w_in[layer]

        hc_mod = modulate(hc, csh1, csc1)
        if last:
            k_c, v_c = jnp.split(hc_mod @ wl[:, ATT_W:3 * ATT_W], 2, axis=-1)
        else:
            q_c, k_c, v_c, pool_c, ga_c, gb_c = jnp.split(hc_mod @ wl, SPLIT_POINTS, axis=-1)
        k_c = split_heads(k_c)
        v_c = split_heads(v_c)

        q, k, v, pool_in, ga, gb = jnp.split(modulate(h, sh1, sc1) @ wl, SPLIT_POINTS, axis=-1)
        y_attn = neighbourhood_attention(split_heads(q), split_heads(k), split_heads(v), k_c, v_c, rpb[layer])
        y_pool = multiscale_pool(pool_in, w_pool_grp[layer], pool_scale[layer])
        y = merge_branches(y_attn, y_pool, ga, gb, w_attn_proj[layer], w_pool_proj[layer], w_out[layer])
        h_new = layer_norm(alpha * h + g1 * y, ln1_g[layer], ln1_b[layer])

        ffn = hierarchical_moe(modulate(h_new, sh2, sc2), w_router_group[layer], b_router_group[layer],
                               w_router_expert[layer], b_router_expert[layer],
                               w_expert_gate[layer], w_expert_up[layer], w_expert_down[layer])
        h_new = layer_norm(alpha * h_new + g2 * ffn, ln2_g[layer], ln2_b[layer])

        if not last:
            yc_attn = context_attention(split_heads(q_c), k_c, v_c)
            yc_pool = multiscale_pool(pool_c, w_pool_grp[layer], pool_scale[layer])
            yc = merge_branches(yc_attn, yc_pool, ga_c, gb_c, w_attn_proj[layer], w_pool_proj[layer], w_out[layer])
            hc = layer_norm(alpha * hc + cg1 * yc, ln1_g[layer], ln1_b[layer])
            ffn_c = hierarchical_moe(modulate(hc, csh2, csc2), w_router_group[layer], b_router_group[layer],
                                     w_router_expert[layer], b_router_expert[layer],
                                     w_expert_gate[layer], w_expert_up[layer], w_expert_down[layer])
            hc = layer_norm(alpha * hc + cg2 * ffn_c, ln2_g[layer], ln2_b[layer])
        h = h_new

    return h
```

```cpp
#include <hip/hip_runtime.h>
#include <hip/hip_cooperative_groups.h>
#include <cstdio>
namespace cg = cooperative_groups;

#ifndef N_LAUNCH_MODE
#define N_LAUNCH_MODE 0
#endif

typedef unsigned short u16;
typedef __attribute__((ext_vector_type(8))) short bf16x8;
typedef __attribute__((ext_vector_type(16))) float f32x16;
#define DI __device__ __forceinline__
#define MFMA(a, b, c) __builtin_amdgcn_mfma_f32_32x32x16_bf16((a), (b), (c), 0, 0, 0)

constexpr int D = 1024, L = 16384, CTX = 256, MT = L + CTX;
constexpr int ATT = 512, PROJ = 4096;
constexpr int NE = 32, DE = 512, CAP = 16384;
constexpr float ALPHA = 1.189207115002721f;
constexpr float LN_EPS = 1e-5f;
constexpr int NPHASE = 10;

constexpr size_t al(size_t x) { return (x + 255) & ~(size_t)255; }
constexpr size_t WS_WIN   = 0;
constexpr size_t WS_WA    = WS_WIN  + al((size_t)PROJ * D * 2);
constexpr size_t WS_WPC   = WS_WA   + al((size_t)D * ATT * 2);
constexpr size_t WS_WOUT  = WS_WPC  + al((size_t)D * ATT * 2);
constexpr size_t WS_WGU   = WS_WOUT + al((size_t)D * D * 2);
constexpr size_t WS_WDN   = WS_WGU  + al((size_t)NE * 1024 * D * 2);
constexpr size_t WS_WRT   = WS_WDN  + al((size_t)NE * D * DE * 2);
constexpr size_t WS_MODP  = WS_WRT  + al((size_t)36 * D * 4);
constexpr size_t WS_CNT   = WS_MODP + al((size_t)16 * 2 * 6144 * 4);
constexpr size_t WS_LIST  = WS_CNT  + 256;
constexpr size_t WS_CW    = WS_LIST + al((size_t)NE * CAP * 4);
constexpr size_t WS_TINFO = WS_CW   + al((size_t)NE * CAP * 4);
constexpr size_t WS_HM    = WS_TINFO + al((size_t)L * 16);
constexpr size_t WS_VT    = WS_HM   + (size_t)MT * D * 2;
constexpr size_t WS_POOL  = WS_VT   + (size_t)ATT * MT * 2;
constexpr size_t WS_Q     = WS_POOL + (size_t)L * ATT * 2;
constexpr size_t WS_K     = WS_Q    + (size_t)MT * ATT * 2;
constexpr size_t WS_SA    = WS_K    + (size_t)MT * ATT * 2;
constexpr size_t WS_SB    = WS_SA   + (size_t)L * D * 2;
constexpr size_t WS_END   = WS_SB   + (size_t)L * D * 2;
constexpr size_t WS_YATT  = WS_HM;
constexpr size_t WS_POOLED= WS_HM + (size_t)L * ATT * 2;
constexpr size_t WS_Z     = WS_Q;
constexpr size_t WS_Y     = WS_SA;
constexpr size_t WS_HM2   = WS_HM;
constexpr size_t WS_ACT   = WS_Q;
constexpr size_t WS_OUTP  = WS_HM;
static_assert(WS_HM + (size_t)2 * L * D * 2 <= WS_Q, "outp must fit in HM+VT+POOL");
static_assert((size_t)2 * L * DE * 2 <= (size_t)2 * MT * ATT * 2, "act must fit in Q+K");

struct Params {
    const float *x, *c, *ctx, *c_ctx, *ln_in_g, *ln_in_b, *w_mod, *b_mod, *w_in, *rpb, *w_pool_grp, *pool_scale,
                *w_attn_proj, *w_pool_proj, *w_out, *ln1_g, *ln1_b, *w_rg, *b_rg, *w_re, *b_re, *w_gate, *w_up, *w_down, *ln2_g, *ln2_b;
    float* out;
    unsigned char* ws;
    int ph_lo, ph_hi;
};

DI u16 f2bf(float x) { __bf16 b = (__bf16)x; return __builtin_bit_cast(u16, b); }
DI float bf2f(u16 b) { return __uint_as_float(((unsigned)b) << 16); }
DI unsigned pack2(float a, float b) { return (unsigned)f2bf(a) | ((unsigned)f2bf(b) << 16); }
DI float wave_sum(float v) {
#pragma unroll
    for (int o = 32; o > 0; o >>= 1) v += __shfl_xor(v, o);
    return v;
}
DI float sigmoidf_(float x) { return 1.f / (1.f + __expf(-x)); }
DI float siluf_(float x) { return x / (1.f + __expf(-x)); }

constexpr int LROW = 144;
constexpr int TILEB = 128 * LROW;
constexpr int LDS_BYTES = 4 * TILEB;

DI void gemm_mainloop(f32x16 (&acc)[2][2], const u16* const (&ap)[4], const u16* const (&bp)[4], int K, char* lds) {
    const int t = threadIdx.x, lane = t & 63, w = t >> 6, wm = w >> 1, wn = w & 1;
    const int lr = lane & 31, lh = lane >> 5;
    const int srow = t >> 3, sch = t & 7;
    uint4 ra[4], rb[4];
#pragma unroll
    for (int i = 0; i < 4; ++i) { ra[i] = *(const uint4*)(ap[i]); rb[i] = *(const uint4*)(bp[i]); }
#pragma unroll
    for (int i = 0; i < 4; ++i) {
        *(uint4*)(lds + (srow + 32 * i) * LROW + sch * 16) = ra[i];
        *(uint4*)(lds + TILEB + (srow + 32 * i) * LROW + sch * 16) = rb[i];
    }
    __syncthreads();
    const int KT = K >> 6;
    for (int kt = 0; kt < KT; ++kt) {
        const int buf = kt & 1;
        if (kt + 1 < KT) {
#pragma unroll
            for (int i = 0; i < 4; ++i) { ra[i] = *(const uint4*)(ap[i] + (kt + 1) * 64); rb[i] = *(const uint4*)(bp[i] + (kt + 1) * 64); }
        }
        const char* la = lds + buf * 2 * TILEB;
        const char* lb = la + TILEB;
#pragma unroll
        for (int ks = 0; ks < 4; ++ks) {
            bf16x8 a0 = *(const bf16x8*)(la + (wm * 64 + lr) * LROW + (ks * 2 + lh) * 16);
            bf16x8 a1 = *(const bf16x8*)(la + (wm * 64 + 32 + lr) * LROW + (ks * 2 + lh) * 16);
            bf16x8 b0 = *(const bf16x8*)(lb + (wn * 64 + lr) * LROW + (ks * 2 + lh) * 16);
            bf16x8 b1 = *(const bf16x8*)(lb + (wn * 64 + 32 + lr) * LROW + (ks * 2 + lh) * 16);
            acc[0][0] = MFMA(a0, b0, acc[0][0]);
            acc[0][1] = MFMA(a0, b1, acc[0][1]);
            acc[1][0] = MFMA(a1, b0, acc[1][0]);
            acc[1][1] = MFMA(a1, b1, acc[1][1]);
        }
        if (kt + 1 < KT) {
            char* wa = lds + (buf ^ 1) * 2 * TILEB;
#pragma unroll
            for (int i = 0; i < 4; ++i) {
                *(uint4*)(wa + (srow + 32 * i) * LROW + sch * 16) = ra[i];
                *(uint4*)(wa + TILEB + (srow + 32 * i) * LROW + sch * 16) = rb[i];
            }
        }
        __syncthreads();
    }
}

DI void zero_acc(f32x16 (&acc)[2][2]) {
#pragma unroll
    for (int i = 0; i < 2; ++i)
#pragma unroll
        for (int j = 0; j < 2; ++j)
#pragma unroll
            for (int r = 0; r < 16; ++r) acc[i][j][r] = 0.f;
}

DI void rows_contig(const u16* (&pp)[4], const u16* base, int ld, int row0) {
    const int t = threadIdx.x, srow = t >> 3, sch = t & 7;
#pragma unroll
    for (int i = 0; i < 4; ++i) pp[i] = base + (size_t)(row0 + srow + 32 * i) * ld + sch * 8;
}

constexpr int LDC = 132;
DI void acc_to_lds(const f32x16 (&acc)[2][2], char* lds) {
    float* lc = (float*)lds;
    const int t = threadIdx.x, lane = t & 63, w = t >> 6, wm = w >> 1, wn = w & 1, lr = lane & 31, lh = lane >> 5;
    float* wb = lc + (wm * 64 + lh * 4) * LDC + wn * 64 + lr;
#pragma unroll
    for (int i = 0; i < 2; ++i)
#pragma unroll
        for (int j = 0; j < 2; ++j)
#pragma unroll
            for (int r = 0; r < 16; ++r) wb[(i * 32 + (r >> 2) * 8 + (r & 3)) * LDC + j * 32] = acc[i][j][r];
    __syncthreads();
}
template <class F>
DI void epi_lds(const f32x16 (&acc)[2][2], char* lds, F f) {
    acc_to_lds(acc, lds);
    const float* lc = (const float*)lds;
    const int t = threadIdx.x, c4 = (t & 31) * 4, rb = t >> 5;
#pragma unroll 4
    for (int k = 0; k < 16; ++k) {
        const int rl = rb + 8 * k;
        const float4 v = *(const float4*)(lc + rl * LDC + c4);
        f(k, rl, c4, v);
    }
    __syncthreads();
}
DI uint2 pack4(float4 v) { return make_uint2(pack2(v.x, v.y), pack2(v.z, v.w)); }

DI void transpose_tile(const float* src, int ld_src, u16* dst, int ld_dst, int r0, int c0, int mode, float* lt) {
    const int t = threadIdx.x;
#pragma unroll
    for (int i = 0; i < 4; ++i) {
        const int row = (t >> 4) + 16 * i, c4 = (t & 15) * 4;
        const float4 v = *(const float4*)(src + (size_t)(r0 + row) * ld_src + c0 + c4);
        lt[row * 65 + c4 + 0] = v.x; lt[row * 65 + c4 + 1] = v.y; lt[row * 65 + c4 + 2] = v.z; lt[row * 65 + c4 + 3] = v.w;
    }
    __syncthreads();
    {
        const int c = t >> 2, rc = (t & 3) * 16;
        int cg_ = c0 + c;
        int drow = cg_;
        if (mode == 1) drow = (cg_ >> 5) * 64 + (cg_ & 31);
        else if (mode == 2) drow = (cg_ >> 5) * 64 + (cg_ & 31) + 32;
        unsigned pk[8];
#pragma unroll
        for (int e = 0; e < 8; ++e) pk[e] = pack2(lt[(rc + 2 * e) * 65 + c], lt[(rc + 2 * e + 1) * 65 + c]);
        uint4* dp = (uint4*)(dst + (size_t)drow * ld_dst + r0 + rc);
        dp[0] = make_uint4(pk[0], pk[1], pk[2], pk[3]);
        dp[1] = make_uint4(pk[4], pk[5], pk[6], pk[7]);
    }
    __syncthreads();
}

DI void phase0(const Params& p, char* lds) {
    float* lt = (float*)lds;
    const int t = threadIdx.x;
    u16* wsu = (u16*)p.ws;
    constexpr int I_MOD = 384, I_WIN = 1024, I_WA = 128, I_WOUT = 256, I_WPC = 128, I_G = 4096, I_U = 4096, I_DN = 4096, I_MISC = 1;
    constexpr int TOTAL = I_MOD + I_WIN + I_WA + I_WOUT + I_WPC + I_G + I_U + I_DN + I_MISC;
    for (int it = blockIdx.x; it < TOTAL; it += gridDim.x) {
        int i = it;
        if (i < I_MOD) {
            const int cc = i % 24, kc = i / 24;
            const int col = cc * 256 + t;
            float a0 = 0.f, a1 = 0.f;
            for (int k = kc * 64; k < kc * 64 + 64; ++k) {
                const float wv = p.w_mod[(size_t)k * 6144 + col];
                a0 += siluf_(p.c[k]) * wv;
                a1 += siluf_(p.c_ctx[k]) * wv;
            }
            if (kc == 0) { const float b = p.b_mod[col]; a0 += b; a1 += b; }
            float* modp = (float*)(p.ws + WS_MODP);
            modp[(kc * 2 + 0) * 6144 + col] = a0;
            modp[(kc * 2 + 1) * 6144 + col] = a1;
            continue;
        }
        i -= I_MOD;
        if (i < I_WIN) { transpose_tile(p.w_in, PROJ, (u16*)(p.ws + WS_WIN), D, (i / 64) * 64, (i % 64) * 64, 0, lt); continue; }
        i -= I_WIN;
        if (i < I_WA) { transpose_tile(p.w_attn_proj, D, (u16*)(p.ws + WS_WA), ATT, (i / 16) * 64, (i % 16) * 64, 0, lt); continue; }
        i -= I_WA;
        if (i < I_WOUT) { transpose_tile(p.w_out, D, (u16*)(p.ws + WS_WOUT), D, (i / 16) * 64, (i % 16) * 64, 0, lt); continue; }
        i -= I_WOUT;
        if (i < I_WPC) {
            const int o0 = (i / 8) * 64, i0 = (i % 8) * 64;
            const int o = o0 + (t & 63);
            const int ib = i0 + (t >> 6) * 16;
            const int g = ib >> 7;
            float a[16];
#pragma unroll
            for (int e = 0; e < 16; ++e) a[e] = 0.f;
            for (int j = 0; j < 128; ++j) {
                const float wv = p.w_pool_proj[(size_t)(g * 128 + j) * D + o] * p.pool_scale[g * 128 + j];
#pragma unroll
                for (int e = 0; e < 16; ++e) a[e] += p.w_pool_grp[(size_t)(g * 128 + ((ib + e) & 127)) * 128 + j] * wv;
            }
            unsigned pk[8];
#pragma unroll
            for (int e = 0; e < 8; ++e) pk[e] = pack2(a[2 * e], a[2 * e + 1]);
            uint4* dp = (uint4*)((u16*)(p.ws + WS_WPC) + (size_t)o * ATT + ib);
            dp[0] = make_uint4(pk[0], pk[1], pk[2], pk[3]);
            dp[1] = make_uint4(pk[4], pk[5], pk[6], pk[7]);
            continue;
        }
        i -= I_WPC;
        if (i < I_G) { const int e = i >> 7, j = i & 127;
            transpose_tile(p.w_gate + (size_t)e * D * DE, DE, (u16*)(p.ws + WS_WGU) + (size_t)e * 1024 * D, D, (j / 8) * 64, (j % 8) * 64, 1, lt); continue; }
        i -= I_G;
        if (i < I_U) { const int e = i >> 7, j = i & 127;
            transpose_tile(p.w_up + (size_t)e * D * DE, DE, (u16*)(p.ws + WS_WGU) + (size_t)e * 1024 * D, D, (j / 8) * 64, (j % 8) * 64, 2, lt); continue; }
        i -= I_U;
        if (i < I_DN) { const int e = i >> 7, j = i & 127;
            transpose_tile(p.w_down + (size_t)e * DE * D, D, (u16*)(p.ws + WS_WDN) + (size_t)e * D * DE, DE, (j / 16) * 64, (j % 16) * 64, 0, lt); continue; }
        i -= I_DN;
        {
            float* wrt = (float*)(p.ws + WS_WRT);
            for (int e = t; e < 4 * 1024; e += 256) { const int g = e >> 10, k = e & 1023; wrt[g * 1024 + k] = p.w_rg[k * 4 + g]; }
            for (int e = t; e < 32 * 1024; e += 256) { const int g = e >> 10, k = e & 1023; wrt[(4 + g) * 1024 + k] = p.w_re[k * 32 + g]; }
            if (t < 32) ((int*)(p.ws + WS_CNT))[t] = 0;
        }
    }
    (void)wsu;
}

DI void load_modvec(float* dst, const Params& p, int cond, int vec) {
    const float* modp = (const float*)(p.ws + WS_MODP);
    for (int i = threadIdx.x; i < 1024; i += 256) {
        float s = 0.f;
#pragma unroll
        for (int kc = 0; kc < 16; ++kc) s += modp[(kc * 2 + cond) * 6144 + vec * 1024 + i];
        dst[i] = s;
    }
}

DI void ln_row(float4 (&v)[4], const float* g, const float* b, int lane) {
    float s = 0.f;
#pragma unroll
    for (int j = 0; j < 4; ++j) s += v[j].x + v[j].y + v[j].z + v[j].w;
    const float mu = wave_sum(s) * (1.f / 1024.f);
    float q = 0.f;
#pragma unroll
    for (int j = 0; j < 4; ++j) {
        v[j].x -= mu; v[j].y -= mu; v[j].z -= mu; v[j].w -= mu;
        q += v[j].x * v[j].x + v[j].y * v[j].y + v[j].z * v[j].z + v[j].w * v[j].w;
    }
    const float rstd = rsqrtf(wave_sum(q) * (1.f / 1024.f) + LN_EPS);
#pragma unroll
    for (int j = 0; j < 4; ++j) {
        const float4 gg = *(const float4*)(g + (j * 64 + lane) * 4);
        const float4 bb = *(const float4*)(b + (j * 64 + lane) * 4);
        v[j].x = v[j].x * rstd * gg.x + bb.x; v[j].y = v[j].y * rstd * gg.y + bb.y;
        v[j].z = v[j].z * rstd * gg.z + bb.z; v[j].w = v[j].w * rstd * gg.w + bb.w;
    }
}

DI void phase1(const Params& p, char* lds) {
    float* lm = (float*)lds;
    load_modvec(lm + 0, p, 0, 0); load_modvec(lm + 1024, p, 0, 1);
    load_modvec(lm + 2048, p, 1, 0); load_modvec(lm + 3072, p, 1, 1);
    __syncthreads();
    const int lane = threadIdx.x & 63, w = threadIdx.x >> 6;
    u16* hm = (u16*)(p.ws + WS_HM);
    for (int row = blockIdx.x * 4 + w; row < MT; row += gridDim.x * 4) {
        const float* src = (row < L) ? (p.x + (size_t)row * D) : (p.ctx + (size_t)(row - L) * D);
        const float* sh = lm + ((row < L) ? 0 : 2048);
        const float* sc = sh + 1024;
        float4 v[4];
#pragma unroll
        for (int j = 0; j < 4; ++j) v[j] = *(const float4*)(src + (j * 64 + lane) * 4);
        ln_row(v, p.ln_in_g, p.ln_in_b, lane);
#pragma unroll
        for (int j = 0; j < 4; ++j) {
            const int e = (j * 64 + lane) * 4;
            const float4 s4 = *(const float4*)(sh + e), c4 = *(const float4*)(sc + e);
            const float m0 = v[j].x * (1.f + c4.x) + s4.x, m1 = v[j].y * (1.f + c4.y) + s4.y;
            const float m2 = v[j].z * (1.f + c4.z) + s4.z, m3 = v[j].w * (1.f + c4.w) + s4.w;
            *(uint2*)(hm + (size_t)row * D + e) = make_uint2(pack2(m0, m1), pack2(m2, m3));
        }
    }
}

DI void phase2(const Params& p, char* lds) {
    const u16* hm = (const u16*)(p.ws + WS_HM);
    const u16* wt = (const u16*)(p.ws + WS_WIN);
    u16* Q = (u16*)(p.ws + WS_Q); u16* Kb = (u16*)(p.ws + WS_K); u16* VT = (u16*)(p.ws + WS_VT);
    u16* PL = (u16*)(p.ws + WS_POOL); u16* SA = (u16*)(p.ws + WS_SA); u16* SB = (u16*)(p.ws + WS_SB);
    constexpr int NT = PROJ / 128, MTILES = MT / 128;
    for (int it = blockIdx.x; it < NT * MTILES; it += gridDim.x) {
        const int nt = it % NT, mt = it / NT;
        const int row0 = mt * 128, col0 = nt * 128;
        const u16 *ap[4], *bp[4];
        rows_contig(ap, hm, D, row0);
        rows_contig(bp, wt, D, col0);
        f32x16 acc[2][2];
        zero_acc(acc);
        gemm_mainloop(acc, ap, bp, D, lds);
        if (col0 < 1024) {
            u16* dst = (col0 < 512) ? (Q + col0) : (Kb + (col0 - 512));
            const float sc = (col0 < 512) ? 0.125f : 1.f;
            epi_lds(acc, lds, [&](int k, int rl, int c4, float4 v) {
                v.x *= sc; v.y *= sc; v.z *= sc; v.w *= sc;
                *(uint2*)(dst + (size_t)(row0 + rl) * ATT + c4) = pack4(v); });
        } else if (col0 < 1536) {
            acc_to_lds(acc, lds);
            const float* lc = (const float*)lds;
            const int t = threadIdx.x, col = t & 127, rg0 = t >> 7;
#pragma unroll
            for (int k = 0; k < 8; ++k) {
                const int rg = rg0 + 2 * k;
                float e[8];
#pragma unroll
                for (int q = 0; q < 8; ++q) e[q] = lc[(rg * 8 + q) * LDC + col];
                *(uint4*)(VT + (size_t)(col0 - 1024 + col) * MT + row0 + rg * 8) =
                    make_uint4(pack2(e[0], e[1]), pack2(e[2], e[3]), pack2(e[4], e[5]), pack2(e[6], e[7]));
            }
            __syncthreads();
        } else if (col0 < 2048) {
            if (row0 < L) {
                u16* dst = PL + (col0 - 1536);
                epi_lds(acc, lds, [&](int k, int rl, int c4, float4 v) {
                    *(uint2*)(dst + (size_t)(row0 + rl) * ATT + c4) = pack4(v); });
            }
        } else {
            if (row0 < L) {
                u16* dst = (col0 < 3072) ? (SA + (col0 - 2048)) : (SB + (col0 - 3072));
                epi_lds(acc, lds, [&](int k, int rl, int c4, float4 v) {
                    v.x = sigmoidf_(v.x); v.y = sigmoidf_(v.y); v.z = sigmoidf_(v.z); v.w = sigmoidf_(v.w);
                    *(uint2*)(dst + (size_t)(row0 + rl) * D + c4) = pack4(v); });
            }
        }
    }
}

DI bf16x8 pack8(float a0, float a1, float a2, float a3, float a4, float a5, float a6, float a7) {
    uint4 u = make_uint4(pack2(a0, a1), pack2(a2, a3), pack2(a4, a5), pack2(a6, a7));
    return __builtin_bit_cast(bf16x8, u);
}

DI void attn_item(const Params& p, int r, int hp, char* lds) {
    const int t = threadIdx.x, lane = t & 63, w = t >> 6;
    const int hl = w >> 1, head = hp * 2 + hl, qh = w & 1;
    const int lr = lane & 31, lh = lane >> 5;
    const int qc = qh * 32 + lr, tok = r * 64 + qc;
    const u16* Q = (const u16*)(p.ws + WS_Q); const u16* Kb = (const u16*)(p.ws + WS_K); const u16* VT = (const u16*)(p.ws + WS_VT);
    u16* YA = (u16*)(p.ws + WS_YATT);
    char* lk = lds; char* lv = lds + 2 * 64 * LROW; float* lbias = (float*)(lds + 4 * 64 * LROW);
    __syncthreads();
    for (int i = t; i < 2 * 465; i += 256) lbias[i] = p.rpb[hp * 2 * 465 + i];
    bf16x8 qf[4];
#pragma unroll
    for (int ks = 0; ks < 4; ++ks) qf[ks] = *(const bf16x8*)(Q + (size_t)tok * ATT + head * 64 + ks * 16 + lh * 8);
    f32x16 o0, o1;
#pragma unroll
    for (int i = 0; i < 16; ++i) { o0[i] = 0.f; o1[i] = 0.f; }
    float m = -1e30f, lsum = 0.f;
    const int rs = min(max(r - 4, 0), 256 - 8);
    const int cs = min(max(qc - 8, 0), 48);
    for (int tile = 0; tile < 12; ++tile) {
        const int tokbase = (tile < 4) ? (L + tile * 64) : ((rs + tile - 4) * 64);
        __syncthreads();
#pragma unroll
        for (int i = 0; i < 4; ++i) {
            const int c = t + 256 * i, hh = c >> 9, key = (c >> 3) & 63, ch = c & 7;
            const uint4 v = *(const uint4*)(Kb + (size_t)(tokbase + key) * ATT + (hp * 2 + hh) * 64 + ch * 8);
            *(uint4*)(lk + (hh * 64 + key) * LROW + ch * 16) = v;
        }
#pragma unroll
        for (int i = 0; i < 4; ++i) {
            const int c = t + 256 * i, hh = c >> 9, d = (c >> 3) & 63, ch = c & 7;
            const uint4 v = *(const uint4*)(VT + (size_t)((hp * 2 + hh) * 64 + d) * MT + tokbase + ch * 8);
            char* rowp = lv + (hh * 64 + d) * LROW;
            *(uint2*)(rowp + (16 * (ch >> 1) + 4 * (ch & 1)) * 2) = make_uint2(v.x, v.y);
            *(uint2*)(rowp + (16 * (ch >> 1) + 8 + 4 * (ch & 1)) * 2) = make_uint2(v.z, v.w);
        }
        __syncthreads();
#pragma unroll
        for (int sub = 0; sub < 2; ++sub) {
            f32x16 s;
#pragma unroll
            for (int i = 0; i < 16; ++i) s[i] = 0.f;
#pragma unroll
            for (int ks = 0; ks < 4; ++ks) {
                const bf16x8 kf = *(const bf16x8*)(lk + (hl * 64 + sub * 32 + lr) * LROW + (ks * 2 + lh) * 16);
                s = MFMA(kf, qf[ks], s);
            }
            if (tile >= 4) {
                const float* bt = lbias + hl * 465 + ((rs + tile - 4) - r + 7) * 31;
#pragma unroll
                for (int i = 0; i < 16; ++i) {
                    const int kc = sub * 32 + (i & 3) + 8 * (i >> 2) + 4 * lh;
                    const bool valid = (kc >= cs) && (kc < cs + 16);
                    const int co = min(max(kc - qc, -15), 15) + 15;
                    s[i] = valid ? (s[i] + bt[co]) : -1e30f;
                }
            }
            float tmax = s[0];
#pragma unroll
            for (int i = 1; i < 16; ++i) tmax = fmaxf(tmax, s[i]);
            tmax = fmaxf(tmax, __shfl_xor(tmax, 32));
            const float mnew = fmaxf(m, tmax);
            const float alpha = __expf(m - mnew);
            float psum = 0.f;
#pragma unroll
            for (int i = 0; i < 16; ++i) { s[i] = __expf(s[i] - mnew); psum += s[i]; }
            psum += __shfl_xor(psum, 32);
            lsum = lsum * alpha + psum;
            m = mnew;
#pragma unroll
            for (int i = 0; i < 16; ++i) { o0[i] *= alpha; o1[i] *= alpha; }
#pragma unroll
            for (int j = 0; j < 2; ++j) {
                const bf16x8 pf = pack8(s[8 * j + 0], s[8 * j + 1], s[8 * j + 2], s[8 * j + 3], s[8 * j + 4], s[8 * j + 5], s[8 * j + 6], s[8 * j + 7]);
                const bf16x8 v0 = *(const bf16x8*)(lv + (hl * 64 + lr) * LROW + (sub * 32 + 16 * j + 8 * lh) * 2);
                const bf16x8 v1 = *(const bf16x8*)(lv + (hl * 64 + 32 + lr) * LROW + (sub * 32 + 16 * j + 8 * lh) * 2);
                o0 = MFMA(v0, pf, o0);
                o1 = MFMA(v1, pf, o1);
            }
        }
    }
    const float inv = 1.f / lsum;
#pragma unroll
    for (int q = 0; q < 4; ++q) {
        const int d0 = q * 8 + lh * 4;
        *(uint2*)(YA + (size_t)tok * ATT + head * 64 + d0) =
            make_uint2(pack2(o0[q * 4] * inv, o0[q * 4 + 1] * inv), pack2(o0[q * 4 + 2] * inv, o0[q * 4 + 3] * inv));
        *(uint2*)(YA + (size_t)tok * ATT + head * 64 + 32 + d0) =
            make_uint2(pack2(o1[q * 4] * inv, o1[q * 4 + 1] * inv), pack2(o1[q * 4 + 2] * inv, o1[q * 4 + 3] * inv));
    }
}

DI void pool_item(const Params& p, int pt) {
    const int t = threadIdx.x;
    const unsigned* PL = (const unsigned*)(p.ws + WS_POOL);
    unsigned* PD = (unsigned*)(p.ws + WS_POOLED);
    const int g = t >> 6;
    const int half = 1 << g;
    for (int tok = pt * 64; tok < pt * 64 + 64; ++tok) {
        const int lo = max(tok - half, 0), hi = min(tok + half, L);
        float s0 = 0.f, s1 = 0.f;
        for (int tt = lo; tt < hi; ++tt) {
            const unsigned u = PL[(size_t)tt * 256 + t];
            s0 += bf2f((u16)(u & 0xffff)); s1 += bf2f((u16)(u >> 16));
        }
        const float invn = 1.f / (float)(hi - lo);
        const unsigned u = PL[(size_t)tok * 256 + t];
        PD[(size_t)tok * 256 + t] = pack2(s0 * invn - bf2f((u16)(u & 0xffff)), s1 * invn - bf2f((u16)(u >> 16)));
    }
}

DI void phase3(const Params& p, char* lds) {
    constexpr int N_ATT = 256 * 4, N_POOL = 256;
    for (int it = blockIdx.x; it < N_ATT + N_POOL; it += gridDim.x) {
        if (it < N_ATT) attn_item(p, it >> 2, it & 3, lds);
        else pool_item(p, it - N_ATT);
    }
}

DI void phase4(const Params& p, char* lds) {
    const u16* YA = (const u16*)(p.ws + WS_YATT); const u16* PD = (const u16*)(p.ws + WS_POOLED);
    const u16* WA = (const u16*)(p.ws + WS_WA); const u16* WPC = (const u16*)(p.ws + WS_WPC);
    const u16* SA = (const u16*)(p.ws + WS_SA); const u16* SB = (const u16*)(p.ws + WS_SB);
    u16* Z = (u16*)(p.ws + WS_Z);
    constexpr int NT = D / 128, MTILES = L / 128;
    for (int it = blockIdx.x; it < NT * MTILES; it += gridDim.x) {
        const int nt = it % NT, mt = it / NT;
        const int row0 = mt * 128, col0 = nt * 128;
        const u16 *ap[4], *bp[4];
        f32x16 acc[2][2];
        rows_contig(ap, YA, ATT, row0); rows_contig(bp, WA, ATT, col0);
        zero_acc(acc);
        gemm_mainloop(acc, ap, bp, ATT, lds);
        epi_lds(acc, lds, [&](int k, int rl, int c4, float4 v) {
            const uint2 g = *(const uint2*)(SA + (size_t)(row0 + rl) * D + col0 + c4);
            float4 z;
            z.x = v.x * bf2f((u16)(g.x & 0xffff)); z.y = v.y * bf2f((u16)(g.x >> 16));
            z.z = v.z * bf2f((u16)(g.y & 0xffff)); z.w = v.w * bf2f((u16)(g.y >> 16));
            *(uint2*)(Z + (size_t)(row0 + rl) * D + col0 + c4) = pack4(z); });
        rows_contig(ap, PD, ATT, row0); rows_contig(bp, WPC, ATT, col0);
        zero_acc(acc);
        gemm_mainloop(acc, ap, bp, ATT, lds);
        epi_lds(acc, lds, [&](int k, int rl, int c4, float4 v) {
            const uint2 g = *(const uint2*)(SB + (size_t)(row0 + rl) * D + col0 + c4);
            float4 z;
            const uint2 zp = *(const uint2*)(Z + (size_t)(row0 + rl) * D + col0 + c4);
            z.x = bf2f((u16)(zp.x & 0xffff)) + v.x * bf2f((u16)(g.x & 0xffff)); z.y = bf2f((u16)(zp.x >> 16)) + v.y * bf2f((u16)(g.x >> 16));
            z.z = bf2f((u16)(zp.y & 0xffff)) + v.z * bf2f((u16)(g.y & 0xffff)); z.w = bf2f((u16)(zp.y >> 16)) + v.w * bf2f((u16)(g.y >> 16));
            *(uint2*)(Z + (size_t)(row0 + rl) * D + col0 + c4) = pack4(z); });
    }
}

DI void phase5(const Params& p, char* lds) {
    const u16* Z = (const u16*)(p.ws + WS_Z); const u16* WO = (const u16*)(p.ws + WS_WOUT);
    float* Y = (float*)(p.ws + WS_Y);
    constexpr int NT = D / 128, MTILES = L / 128;
    for (int it = blockIdx.x; it < NT * MTILES; it += gridDim.x) {
        const int nt = it % NT, mt = it / NT;
        const int row0 = mt * 128, col0 = nt * 128;
        const u16 *ap[4], *bp[4];
        rows_contig(ap, Z, D, row0); rows_contig(bp, WO, D, col0);
        f32x16 acc[2][2];
        zero_acc(acc);
        gemm_mainloop(acc, ap, bp, D, lds);
        epi_lds(acc, lds, [&](int k, int rl, int c4, float4 v) {
            *(float4*)(Y + (size_t)(row0 + rl) * D + col0 + c4) = v; });
    }
}

DI void phase6(const Params& p, char* lds) {
    float* lm = (float*)lds;
    load_modvec(lm, p, 0, 2); load_modvec(lm + 1024, p, 0, 3); load_modvec(lm + 2048, p, 0, 4);
    __syncthreads();
    const int lane = threadIdx.x & 63, w = threadIdx.x >> 6;
    float* Y = (float*)(p.ws + WS_Y);
    u16* HM2 = (u16*)(p.ws + WS_HM2);
    const float* wrt = (const float*)(p.ws + WS_WRT);
    int* cnt = (int*)(p.ws + WS_CNT); int* list = (int*)(p.ws + WS_LIST); float* cw = (float*)(p.ws + WS_CW);
    int4* tinfo = (int4*)(p.ws + WS_TINFO);
    for (int row = blockIdx.x * 4 + w; row < L; row += gridDim.x * 4) {
        float4 v[4], y[4];
#pragma unroll
        for (int j = 0; j < 4; ++j) { v[j] = *(const float4*)(p.x + (size_t)row * D + (j * 64 + lane) * 4); y[j] = *(const float4*)(Y + (size_t)row * D + (j * 64 + lane) * 4); }
        ln_row(v, p.ln_in_g, p.ln_in_b, lane);
#pragma unroll
        for (int j = 0; j < 4; ++j) {
            const float4 g1 = *(const float4*)(lm + (j * 64 + lane) * 4);
            v[j].x = ALPHA * v[j].x + g1.x * y[j].x; v[j].y = ALPHA * v[j].y + g1.y * y[j].y;
            v[j].z = ALPHA * v[j].z + g1.z * y[j].z; v[j].w = ALPHA * v[j].w + g1.w * y[j].w;
        }
        ln_row(v, p.ln1_g, p.ln1_b, lane);
#pragma unroll
        for (int j = 0; j < 4; ++j) {
            const int e = (j * 64 + lane) * 4;
            *(float4*)(Y + (size_t)row * D + e) = v[j];
            const float4 s4 = *(const float4*)(lm + 1024 + e), c4 = *(const float4*)(lm + 2048 + e);
            v[j].x = v[j].x * (1.f + c4.x) + s4.x; v[j].y = v[j].y * (1.f + c4.y) + s4.y;
            v[j].z = v[j].z * (1.f + c4.z) + s4.z; v[j].w = v[j].w * (1.f + c4.w) + s4.w;
            *(uint2*)(HM2 + (size_t)row * D + e) = make_uint2(pack2(v[j].x, v[j].y), pack2(v[j].z, v[j].w));
        }
        float lg[4];
#pragma unroll
        for (int g = 0; g < 4; ++g) {
            float s = 0.f;
#pragma unroll
            for (int j = 0; j < 4; ++j) {
                const float4 wv = *(const float4*)(wrt + g * 1024 + (j * 64 + lane) * 4);
                s += v[j].x * wv.x + v[j].y * wv.y + v[j].z * wv.z + v[j].w * wv.w;
            }
            lg[g] = wave_sum(s) + p.b_rg[g];
        }
        int gsel = 0; float gmax = lg[0];
#pragma unroll
        for (int g = 1; g < 4; ++g) if (lg[g] > gmax) { gmax = lg[g]; gsel = g; }
        float gden = 0.f;
#pragma unroll
        for (int g = 0; g < 4; ++g) gden += __expf(lg[g] - gmax);
        const float pg = 1.f / gden;
        float le[8];
#pragma unroll
        for (int e = 0; e < 8; ++e) {
            float s = 0.f;
            const float* wp = wrt + (4 + gsel * 8 + e) * 1024;
#pragma unroll
            for (int j = 0; j < 4; ++j) {
                const float4 wv = *(const float4*)(wp + (j * 64 + lane) * 4);
                s += v[j].x * wv.x + v[j].y * wv.y + v[j].z * wv.z + v[j].w * wv.w;
            }
            le[e] = wave_sum(s) + p.b_re[gsel * 8 + e];
        }
        int e1 = 0; float l1 = le[0];
#pragma unroll
        for (int e = 1; e < 8; ++e) if (le[e] > l1) { l1 = le[e]; e1 = e; }
        int e2 = -1; float l2 = -3.0e38f;
#pragma unroll
        for (int e = 0; e < 8; ++e) if (e != e1 && le[e] > l2) { l2 = le[e]; e2 = e; }
        const float ex = __expf(l2 - l1);
        const float c1 = pg / (1.f + ex), c2 = pg * ex / (1.f + ex);
        if (lane == 0) {
            const int E1 = gsel * 8 + e1, E2 = gsel * 8 + e2;
            const int p1 = atomicAdd(&cnt[E1], 1);
            const int p2 = atomicAdd(&cnt[E2], 1);
            list[E1 * CAP + p1] = row; cw[E1 * CAP + p1] = c1;
            list[E2 * CAP + p2] = row; cw[E2 * CAP + p2] = c2;
            tinfo[row] = make_int4(E1, p1, E2, p2);
        }
    }
}

DI void build_offsets(const Params& p, int* loff, int* ltoff) {
    const int* cnt = (const int*)(p.ws + WS_CNT);
    if (threadIdx.x == 0) {
        int o = 0, to = 0;
        for (int e = 0; e < NE; ++e) { loff[e] = o; ltoff[e] = to; const int c = cnt[e]; o += c; to += (c + 127) >> 7; }
        loff[NE] = o; ltoff[NE] = to;
    }
    __syncthreads();
}

DI void phase7(const Params& p, char* lds) {
    int* loff = (int*)(lds + LDS_BYTES); int* ltoff = loff + 40;
    build_offsets(p, loff, ltoff);
    const int* cnt = (const int*)(p.ws + WS_CNT); const int* list = (const int*)(p.ws + WS_LIST); const float* cw = (const float*)(p.ws + WS_CW);
    const u16* HM2 = (const u16*)(p.ws + WS_HM2); const u16* WGU = (const u16*)(p.ws + WS_WGU);
    u16* ACT = (u16*)(p.ws + WS_ACT);
    const int ntiles = ltoff[NE];
    for (int it = blockIdx.x; it < ntiles * 8; it += gridDim.x) {
        const int nt = it & 7, gt = it >> 3;
        int e = 0;
        while (e < NE - 1 && ltoff[e + 1] <= gt) ++e;
        const int tl = gt - ltoff[e];
        const int c = cnt[e];
        const int t = threadIdx.x, srow = t >> 3, sch = t & 7;
        const u16 *ap[4], *bp[4];
#pragma unroll
        for (int i = 0; i < 4; ++i) {
            int idx = tl * 128 + srow + 32 * i;
            if (idx >= c) idx = c - 1;
            const int tok = list[e * CAP + idx];
            ap[i] = HM2 + (size_t)tok * D + sch * 8;
        }
        rows_contig(bp, WGU + (size_t)e * 1024 * D, D, nt * 128);
        f32x16 acc[2][2];
        zero_acc(acc);
        gemm_mainloop(acc, ap, bp, D, lds);
        {
            acc_to_lds(acc, lds);
            const float* lc = (const float*)lds;
            const int cc = (t & 15) * 4;
            const int gc = (cc >> 5) * 64 + (cc & 31);
#pragma unroll
            for (int k = 0; k < 8; ++k) {
                const int rl = (t >> 4) + 16 * k;
                const int idx = tl * 128 + rl;
                if (idx < c) {
                    const float4 a = *(const float4*)(lc + rl * LDC + gc);
                    const float4 u = *(const float4*)(lc + rl * LDC + gc + 32);
                    const float cwv = cw[e * CAP + idx];
                    float4 o;
                    o.x = siluf_(a.x) * u.x * cwv; o.y = siluf_(a.y) * u.y * cwv; o.z = siluf_(a.z) * u.z * cwv; o.w = siluf_(a.w) * u.w * cwv;
                    *(uint2*)(ACT + (size_t)(loff[e] + idx) * DE + nt * 64 + cc) = pack4(o);
                }
            }
            __syncthreads();
        }
    }
}

DI void phase8(const Params& p, char* lds) {
    int* loff = (int*)(lds + LDS_BYTES); int* ltoff = loff + 40;
    build_offsets(p, loff, ltoff);
    const int* cnt = (const int*)(p.ws + WS_CNT);
    const u16* ACT = (const u16*)(p.ws + WS_ACT); const u16* WDN = (const u16*)(p.ws + WS_WDN);
    u16* OUTP = (u16*)(p.ws + WS_OUTP);
    const int ntiles = ltoff[NE];
    for (int it = blockIdx.x; it < ntiles * 8; it += gridDim.x) {
        const int nt = it & 7, gt = it >> 3;
        int e = 0;
        while (e < NE - 1 && ltoff[e + 1] <= gt) ++e;
        const int tl = gt - ltoff[e];
        const int c = cnt[e];
        const int t = threadIdx.x, srow = t >> 3, sch = t & 7;
        const u16 *ap[4], *bp[4];
#pragma unroll
        for (int i = 0; i < 4; ++i) {
            int idx = tl * 128 + srow + 32 * i;
            if (idx >= c) idx = c - 1;
            ap[i] = ACT + (size_t)(loff[e] + idx) * DE + sch * 8;
        }
        rows_contig(bp, WDN + (size_t)e * D * DE, DE, nt * 128);
        f32x16 acc[2][2];
        zero_acc(acc);
        gemm_mainloop(acc, ap, bp, DE, lds);
        epi_lds(acc, lds, [&](int k, int rl, int c4, float4 v) {
            const int idx = tl * 128 + rl;
            if (idx < c) *(uint2*)(OUTP + (size_t)(loff[e] + idx) * D + nt * 128 + c4) = pack4(v); });
    }
}

DI void phase9(const Params& p, char* lds) {
    float* lm = (float*)lds;
    int* loff = (int*)(lds + 4096); int* ltoff = loff + 40;
    load_modvec(lm, p, 0, 5);
    build_offsets(p, loff, ltoff);
    const int lane = threadIdx.x & 63, w = threadIdx.x >> 6;
    const float* H1 = (const float*)(p.ws + WS_Y);
    const u16* OUTP = (const u16*)(p.ws + WS_OUTP);
    const int4* tinfo = (const int4*)(p.ws + WS_TINFO);
    for (int row = blockIdx.x * 4 + w; row < L; row += gridDim.x * 4) {
        const int4 ti = tinfo[row];
        const u16* r1 = OUTP + (size_t)(loff[ti.x] + ti.y) * D;
        const u16* r2 = OUTP + (size_t)(loff[ti.z] + ti.w) * D;
        float4 v[4];
#pragma unroll
        for (int j = 0; j < 4; ++j) {
            const int e = (j * 64 + lane) * 4;
            const float4 h = *(const float4*)(H1 + (size_t)row * D + e);
            const uint2 a = *(const uint2*)(r1 + e), b = *(const uint2*)(r2 + e);
            const float4 g2 = *(const float4*)(lm + e);
            v[j].x = ALPHA * h.x + g2.x * (bf2f((u16)(a.x & 0xffff)) + bf2f((u16)(b.x & 0xffff)));
            v[j].y = ALPHA * h.y + g2.y * (bf2f((u16)(a.x >> 16)) + bf2f((u16)(b.x >> 16)));
            v[j].z = ALPHA * h.z + g2.z * (bf2f((u16)(a.y & 0xffff)) + bf2f((u16)(b.y & 0xffff)));
            v[j].w = ALPHA * h.w + g2.w * (bf2f((u16)(a.y >> 16)) + bf2f((u16)(b.y >> 16)));
        }
        ln_row(v, p.ln2_g, p.ln2_b, lane);
#pragma unroll
        for (int j = 0; j < 4; ++j) *(float4*)(p.out + (size_t)row * D + (j * 64 + lane) * 4) = v[j];
    }
}

extern __shared__ __attribute__((aligned(16))) char dyn_lds[];
constexpr int LDS_TOTAL = LDS_BYTES + 512;

__global__ void __launch_bounds__(256, 2) fwd_mega(Params p) {
    cg::grid_group grid = cg::this_grid();
    char* lds = dyn_lds;
#define RUN_PHASE(n) if (p.ph_lo <= n && n < p.ph_hi) { phase##n(p, lds); if (n + 1 < p.ph_hi) grid.sync(); }
    RUN_PHASE(0) RUN_PHASE(1) RUN_PHASE(2) RUN_PHASE(3) RUN_PHASE(4)
    RUN_PHASE(5) RUN_PHASE(6) RUN_PHASE(7) RUN_PHASE(8) RUN_PHASE(9)
#undef RUN_PHASE
}

extern "C" void kernel_launch(void* const* d_in, const int* in_sizes, int n_in, void* d_out, int out_size, void* d_ws, size_t ws_size, hipStream_t stream) {
    static int grid_blocks = 0;
    if (!grid_blocks) {
        int dev = 0, cus = 0, per_cu = 0;
        hipGetDevice(&dev);
        hipDeviceGetAttribute(&cus, hipDeviceAttributeMultiprocessorCount, dev);
        hipFuncSetAttribute((const void*)fwd_mega, hipFuncAttributeMaxDynamicSharedMemorySize, LDS_TOTAL);
        hipOccupancyMaxActiveBlocksPerMultiprocessor(&per_cu, (const void*)fwd_mega, 256, LDS_TOTAL);
        if (per_cu < 1) per_cu = 1;
        if (per_cu > 2) per_cu = 2;
        grid_blocks = cus * per_cu;
        if (ws_size < WS_END) fprintf(stderr, "kernel_launch: workspace too small: %zu < %zu\n", ws_size, (size_t)WS_END);
    }
    Params p{};
    const float** pf = (const float**)&p;
    for (int i = 0; i < 26; ++i) pf[i] = (const float*)d_in[i];
    p.out = (float*)d_out;
    p.ws = (unsigned char*)d_ws;
#if N_LAUNCH_MODE == 1
    p.ph_lo = 0; p.ph_hi = NPHASE;
    void* args[] = {&p};
    hipError_t e = hipLaunchCooperativeKernel((const void*)fwd_mega, dim3(grid_blocks), dim3(256), args, LDS_TOTAL, stream);
    if (e != hipSuccess) fprintf(stderr, "cooperative launch failed: %s (grid %d)\n", hipGetErrorString(e), grid_blocks);
#else
    for (int ph = 0; ph < NPHASE; ++ph) {
        p.ph_lo = ph; p.ph_hi = ph + 1;
        hipLaunchKernelGGL(fwd_mega, dim3(grid_blocks), dim3(256), LDS_TOTAL, stream, p);
    }
#endif
}
```

```cpp
#include <hip/hip_runtime.h>
#include <hip/hip_cooperative_groups.h>
#include <cstdio>
namespace cg = cooperative_groups;

#ifndef N_LAUNCH_MODE
#define N_LAUNCH_MODE 1
#endif

typedef unsigned short u16;
typedef __attribute__((ext_vector_type(8))) short bf16x8;
typedef __attribute__((ext_vector_type(16))) float f32x16;
#define DI __device__ __forceinline__
#define MFMA(a, b, c) __builtin_amdgcn_mfma_f32_32x32x16_bf16((a), (b), (c), 0, 0, 0)

constexpr int D = 1024, L = 16384, CTX = 256, MT = L + CTX;
constexpr int ATT = 512, PROJ = 4096;
constexpr int NE = 32, DE = 512, CAP = 16384;
constexpr float ALPHA = 1.189207115002721f;
constexpr float LN_EPS = 1e-5f;
constexpr int NPHASE = 10;
constexpr int NTH = 512, NWV = 8;

constexpr size_t al(size_t x) { return (x + 255) & ~(size_t)255; }
constexpr size_t WS_WIN   = 0;
constexpr size_t WS_WA    = WS_WIN  + al((size_t)PROJ * D * 2);
constexpr size_t WS_WPC   = WS_WA   + al((size_t)D * ATT * 2);
constexpr size_t WS_WOUT  = WS_WPC  + al((size_t)D * ATT * 2);
constexpr size_t WS_WGU   = WS_WOUT + al((size_t)D * D * 2);
constexpr size_t WS_WDN   = WS_WGU  + al((size_t)NE * 1024 * D * 2);
constexpr size_t WS_WRT   = WS_WDN  + al((size_t)NE * D * DE * 2);
constexpr size_t WS_MODP  = WS_WRT  + al((size_t)36 * D * 4);
constexpr size_t WS_CNT   = WS_MODP + al((size_t)16 * 2 * 6144 * 4);
constexpr size_t WS_LIST  = WS_CNT  + 64 * 256;
constexpr size_t WS_CW    = WS_LIST + al((size_t)NE * CAP * 4);
constexpr size_t WS_TINFO = WS_CW   + al((size_t)NE * CAP * 4);
constexpr size_t WS_BAR   = WS_TINFO + al((size_t)L * 16);
constexpr size_t WS_HM    = WS_BAR  + al((size_t)3456 * 4);
constexpr size_t WS_VT    = WS_HM   + (size_t)MT * D * 2;
constexpr size_t WS_POOL  = WS_VT   + (size_t)ATT * MT * 2;
constexpr size_t WS_Q     = WS_POOL + (size_t)L * ATT * 2;
constexpr size_t WS_K     = WS_Q    + (size_t)MT * ATT * 2;
constexpr size_t WS_SA    = WS_K    + (size_t)MT * ATT * 2;
constexpr size_t WS_SB    = WS_SA   + (size_t)L * D * 2;
constexpr size_t WS_END   = WS_SB   + (size_t)L * D * 2;
constexpr size_t WS_YATT  = WS_HM;
constexpr size_t WS_POOLED= WS_HM + (size_t)L * ATT * 2;
constexpr size_t WS_Z     = WS_Q;
constexpr size_t WS_Y     = WS_SA;
constexpr size_t WS_HM2   = WS_HM;
constexpr size_t WS_ACT   = WS_Q;
constexpr size_t WS_OUTP  = WS_HM;
static_assert(WS_HM + (size_t)2 * L * D * 2 <= WS_Q, "outp must fit in HM+VT+POOL");
static_assert((size_t)2 * L * DE * 2 <= (size_t)2 * MT * ATT * 2, "act must fit in Q+K");

struct Params {
    const float *x, *c, *ctx, *c_ctx, *ln_in_g, *ln_in_b, *w_mod, *b_mod, *w_in, *rpb, *w_pool_grp, *pool_scale,
                *w_attn_proj, *w_pool_proj, *w_out, *ln1_g, *ln1_b, *w_rg, *b_rg, *w_re, *b_re, *w_gate, *w_up, *w_down, *ln2_g, *ln2_b;
    float* out;
    unsigned char* ws;
    int ph_lo, ph_hi;
};

DI u16 f2bf(float x) { __bf16 b = (__bf16)x; return __builtin_bit_cast(u16, b); }
DI float bf2f(u16 b) { return __uint_as_float(((unsigned)b) << 16); }
typedef __bf16 bf16x2_t __attribute__((ext_vector_type(2)));
typedef float f32x2_t __attribute__((ext_vector_type(2)));
DI unsigned pack2(float a, float b) { f32x2_t v = {a, b}; bf16x2_t r = __builtin_convertvector(v, bf16x2_t); return __builtin_bit_cast(unsigned, r); }
template <int CTRL> DI float dpp_f(float v) { return __int_as_float(__builtin_amdgcn_update_dpp(0, __float_as_int(v), CTRL, 0xF, 0xF, true)); }
DI float rl(float v, int l) { return __int_as_float(__builtin_amdgcn_readlane(__float_as_int(v), l)); }
DI float row_sum16(float v) {
    v += dpp_f<0xB1>(v); v += dpp_f<0x4E>(v); v += dpp_f<0x141>(v); v += dpp_f<0x140>(v); return v;
}
DI float wave_sum(float v) { v = row_sum16(v); return (rl(v, 0) + rl(v, 16)) + (rl(v, 32) + rl(v, 48)); }
DI float sigmoidf_(float x) { return __builtin_amdgcn_rcpf(1.f + __expf(-x)); }
DI float siluf_(float x) { return x * __builtin_amdgcn_rcpf(1.f + __expf(-x)); }

#define LAS __attribute__((address_space(3)))
typedef float f32x4 __attribute__((ext_vector_type(4)));
typedef unsigned u32x4 __attribute__((ext_vector_type(4)));
typedef unsigned u32x2 __attribute__((ext_vector_type(2)));
namespace pg {
constexpr int BM = 256, BK = 64, HALF = 128, HTB = HALF * BK * 2, STAGE_BYTES = 8 * HTB, NXCD = 8, WGM = 8;
DI int lds_byte(int r, int c) { const int st = (r >> 4) * 2 + (c >> 5), rr = r & 15, cc = c & 31, ob = rr * 64 + cc * 2; return st * 1024 + (ob ^ (((ob >> 9) & 1) << 5)); }
DI void stage_rc(int b, int& R, int& C) { const int st = b / 1024, sb = b % 1024, swz = sb ^ (((sb >> 9) & 1) << 5); R = (st >> 1) * 16 + swz / 64; C = (st & 1) * 32 + (swz % 64) / 2; }
DI int perm32(int rho) { const int n = rho >> 4, i = rho & 15; return 8 * (i >> 2) + 4 * n + (i & 3); }
DI unsigned cvt_pk_bf16(float lo, float hi) { return pack2(lo, hi); }

struct Unit { int pm, pn, e, tl, cnt; const char* A; const char* B; unsigned ao[2][2]; };

struct DenseSched {
    const char* A; const char* Bt; int nM, nN, nwg, G, c, K;
    DI void init(const void* A_, const void* Bt_, int M, int N, int K_) { A = (const char*)A_; Bt = (const char*)Bt_; nM = M / BM; nN = N / BM; nwg = nM * nN; G = gridDim.x; c = blockIdx.x; K = K_; }
    DI bool next(int i, Unit& u, const int (&R)[2], const int (&C)[2]) const {
        const long Lx = (long)i * G + c; if (Lx >= nwg) return false;
        int wgid = (int)Lx; { const int q = nwg / NXCD, r = nwg % NXCD, xcd = wgid % NXCD, off = wgid / NXCD; wgid = (xcd < r ? xcd * (q + 1) : r * (q + 1) + (xcd - r) * q) + off; }
        const int nig = WGM * nN, gid = wgid / nig, fm = gid * WGM, gsz = (nM - fm) < WGM ? (nM - fm) : WGM;
        u.pm = fm + ((wgid % nig) % gsz); u.pn = (wgid % nig) / gsz; u.e = 0; u.tl = u.pm; u.cnt = 0x7fffffff;
        u.A = A; u.B = Bt + (size_t)u.pn * BM * K * 2;
#pragma unroll
        for (int h = 0; h < 2; ++h)
#pragma unroll
            for (int j = 0; j < 2; ++j) u.ao[h][j] = (unsigned)((u.pm * BM + h * HALF + R[j]) * K + C[j]) * 2u;
        return true;
    }
};

template <class Epi, class Sched>
DI void gemm_phase(LAS unsigned char* lds, const int K, const Sched& S, const Epi& E) {
    const int tid = threadIdx.x, wid = __builtin_amdgcn_readfirstlane(tid >> 6), lane = tid & 63, wr = wid >> 2, wc = wid & 3, fr = lane & 15, fq = lane >> 4;
    const int nt = K / BK;
    int sR[2], sC[2]; unsigned voffB[2];
#pragma unroll
    for (int i = 0; i < 2; ++i) { stage_rc(tid * 16 + i * 8192, sR[i], sC[i]); const int Rb = Epi::PERM ? ((sR[i] & ~31) + perm32(sR[i] & 31)) : sR[i];
        voffB[i] = (unsigned)(Rb * K + sC[i]) * 2u; }
    const size_t kstep = (size_t)(BK * 2);
    const size_t hstep = (size_t)HALF * K * 2;
    const unsigned ldsw = (unsigned)wid * 1024u;
    const int aoff = lds_byte(wr * 64 + fr, fq * 8), boff = lds_byte(wc * 32 + fr, fq * 8);
#define PG_SA(b, h) (((b) * 2 + (h)) * HTB)
#define PG_SB(b, h) ((4 + (b) * 2 + (h)) * HTB)
#define PG_STAGE(bufoff, gbase, voff) do { _Pragma("unroll") for (int _i = 0; _i < 2; ++_i) \
        __builtin_amdgcn_global_load_lds((const unsigned*)((const char*)(gbase) + (voff)[_i]), (LAS unsigned*)(lds + (bufoff) + ldsw + _i * 8192), 16, 0, 0); } while (0)
#define PG_LDA(dst, b, h) do { _Pragma("unroll") for (int m = 0; m < 4; ++m) _Pragma("unroll") for (int k = 0; k < 2; ++k) dst[m][k] = *(const LAS bf16x8*)(lds + PG_SA(b, h) + aoff + m * 2048 + k * 1024); } while (0)
#define PG_LDB(dst, b, h) do { _Pragma("unroll") for (int n = 0; n < 2; ++n) _Pragma("unroll") for (int k = 0; k < 2; ++k) dst[n][k] = *(const LAS bf16x8*)(lds + PG_SB(b, h) + boff + n * 2048 + k * 1024); } while (0)
#define PG_MMA(ai, bj, At, Bt) do { __builtin_amdgcn_s_setprio(1); _Pragma("unroll") for (int m = 0; m < 4; ++m) _Pragma("unroll") for (int n = 0; n < 2; ++n) _Pragma("unroll") for (int k = 0; k < 2; ++k) \
        acc[ai][bj][m][n] = __builtin_amdgcn_mfma_f32_16x16x32_bf16(Bt[n][k], At[m][k], acc[ai][bj][m][n], 0, 0, 0); __builtin_amdgcn_s_setprio(0); } while (0)
#define PG_WAIT_V(n) asm volatile("s_waitcnt vmcnt(" #n ")" ::: "memory")
#define PG_WAIT_L(n) asm volatile("s_waitcnt lgkmcnt(" #n ")" ::: "memory")
#define PG_BAR __builtin_amdgcn_s_barrier()
#define PG_SCHED __builtin_amdgcn_sched_barrier(0)
    Unit cur, nxt; int ui = 0;
    if (!S.next(0, cur, sR, sC)) return;
    f32x4 acc[2][2][4][2];
#pragma unroll
    for (int a = 0; a < 2; ++a)
#pragma unroll
        for (int b = 0; b < 2; ++b)
#pragma unroll
            for (int m = 0; m < 4; ++m)
#pragma unroll
                for (int n = 0; n < 2; ++n) acc[a][b][m][n] = (f32x4){0.f, 0.f, 0.f, 0.f};
    bf16x8 At[4][2], B0[2][2], B1[2][2];
    PG_STAGE(PG_SB(0, 0), cur.B, voffB); PG_STAGE(PG_SB(0, 1), cur.B + hstep, voffB); PG_STAGE(PG_SA(0, 0), cur.A, cur.ao[0]); PG_STAGE(PG_SA(0, 1), cur.A, cur.ao[1]);
    if (wr == 1) PG_BAR;
    PG_WAIT_V(2); PG_BAR;
    PG_STAGE(PG_SB(1, 0), cur.B + kstep, voffB); PG_STAGE(PG_SA(1, 0), cur.A + kstep, cur.ao[0]); PG_STAGE(PG_SB(1, 1), cur.B + hstep + kstep, voffB);
    PG_WAIT_V(6); PG_BAR;
    for (;;) {
        const bool has_next = S.next(ui + 1, nxt, sR, sC);
        if (!has_next) nxt = cur;
        for (int t = 0; t < nt; t += 2) {
            const bool last = (t == nt - 2);
            const char* a1 = cur.A + (size_t)(t + 1) * kstep;
            const char* a2 = last ? nxt.A : cur.A + (size_t)(t + 2) * kstep; const char* b2 = last ? nxt.B : cur.B + (size_t)(t + 2) * kstep;
            const char* a3 = a2 + kstep; const char* b3 = b2 + kstep;
            unsigned s0[2], s1[2];
            s0[0] = last ? nxt.ao[0][0] : cur.ao[0][0]; s0[1] = last ? nxt.ao[0][1] : cur.ao[0][1];
            s1[0] = last ? nxt.ao[1][0] : cur.ao[1][0]; s1[1] = last ? nxt.ao[1][1] : cur.ao[1][1];
            PG_LDB(B0, 0, 0); PG_LDB(B1, 0, 1); PG_SCHED; PG_LDA(At, 0, 0); PG_STAGE(PG_SA(1, 1), a1, cur.ao[1]);
            PG_WAIT_V(8); PG_WAIT_L(0); PG_BAR; PG_MMA(0, 0, At, B0); PG_MMA(0, 1, At, B1); PG_BAR; PG_SCHED;
            PG_LDA(At, 0, 1); PG_STAGE(PG_SB(0, 0), b2, voffB); PG_STAGE(PG_SB(0, 1), b2 + hstep, voffB); PG_STAGE(PG_SA(0, 0), a2, s0);
            PG_WAIT_V(8); PG_WAIT_L(0); PG_BAR; PG_MMA(1, 0, At, B0); PG_MMA(1, 1, At, B1); PG_BAR; PG_SCHED;
            PG_LDB(B0, 1, 0); PG_LDB(B1, 1, 1); PG_SCHED; PG_LDA(At, 1, 0); PG_STAGE(PG_SA(0, 1), a2, s1);
            PG_WAIT_V(8); PG_WAIT_L(0); PG_BAR; PG_MMA(0, 0, At, B0); PG_MMA(0, 1, At, B1); PG_BAR; PG_SCHED;
            PG_LDA(At, 1, 1); PG_STAGE(PG_SB(1, 0), b3, voffB); PG_STAGE(PG_SB(1, 1), b3 + hstep, voffB); PG_STAGE(PG_SA(1, 0), a3, s0);
            PG_WAIT_V(8); PG_WAIT_L(0); PG_BAR; PG_MMA(1, 0, At, B0); PG_MMA(1, 1, At, B1); PG_BAR; PG_SCHED;
        }
        if (wr == 0) PG_BAR;
        E(acc, cur, wr, wc, fr, fq);
        if (!has_next) break;
#pragma unroll
        for (int a = 0; a < 2; ++a)
#pragma unroll
            for (int b = 0; b < 2; ++b)
#pragma unroll
                for (int m = 0; m < 4; ++m)
#pragma unroll
                    for (int n = 0; n < 2; ++n) acc[a][b][m][n] = (f32x4){0.f, 0.f, 0.f, 0.f};
        cur = nxt; ++ui;
        if (wr == 1) PG_BAR;
    }
    PG_WAIT_V(0);
    PG_BAR;
#undef PG_SA
#undef PG_SB
#undef PG_STAGE
#undef PG_LDA
#undef PG_LDB
#undef PG_MMA
#undef PG_WAIT_V
#undef PG_WAIT_L
#undef PG_BAR
#undef PG_SCHED
}
}

DI u32x4 pack8v(const f32x4& v0, const f32x4& v1) {
    u32x4 w; w.x = pg::cvt_pk_bf16(v0[0], v0[1]); w.y = pg::cvt_pk_bf16(v0[2], v0[3]); w.z = pg::cvt_pk_bf16(v1[0], v1[1]); w.w = pg::cvt_pk_bf16(v1[2], v1[3]); return w;
}
DI float bflo(unsigned u) { return __uint_as_float(u << 16); }
DI float bfhi(unsigned u) { return __uint_as_float(u & 0xffff0000u); }

struct TpDesc { const float* src; u16* dst; int ld_src, ld_dst, r0, c0, mode; };
constexpr int TP_WIN = 512, TP_WA = 64, TP_WOUT = 128, TP_G = 2048, TP_U = 2048, TP_DN = 2048;
constexpr int TP_TOTAL = TP_WIN + TP_WA + TP_WOUT + TP_G + TP_U + TP_DN;
DI TpDesc tp_decode(const Params& p, int i) {
    TpDesc d;
    if (i < TP_WIN) { d.src = p.w_in; d.ld_src = PROJ; d.dst = (u16*)(p.ws + WS_WIN); d.ld_dst = D; d.r0 = (i / 32) * 64; d.c0 = (i % 32) * 128; d.mode = 0; return d; }
    i -= TP_WIN;
    if (i < TP_WA) { d.src = p.w_attn_proj; d.ld_src = D; d.dst = (u16*)(p.ws + WS_WA); d.ld_dst = ATT; d.r0 = (i / 8) * 64; d.c0 = (i % 8) * 128; d.mode = 0; return d; }
    i -= TP_WA;
    if (i < TP_WOUT) { d.src = p.w_out; d.ld_src = D; d.dst = (u16*)(p.ws + WS_WOUT); d.ld_dst = D; d.r0 = (i / 8) * 64; d.c0 = (i % 8) * 128; d.mode = 0; return d; }
    i -= TP_WOUT;
    if (i < TP_G) { const int e = i >> 6, j = i & 63;
        d.src = p.w_gate + (size_t)e * D * DE; d.ld_src = DE; d.dst = (u16*)(p.ws + WS_WGU) + (size_t)e * 1024 * D; d.ld_dst = D; d.r0 = (j / 4) * 64; d.c0 = (j % 4) * 128; d.mode = 1; return d; }
    i -= TP_G;
    if (i < TP_U) { const int e = i >> 6, j = i & 63;
        d.src = p.w_up + (size_t)e * D * DE; d.ld_src = DE; d.dst = (u16*)(p.ws + WS_WGU) + (size_t)e * 1024 * D; d.ld_dst = D; d.r0 = (j / 4) * 64; d.c0 = (j % 4) * 128; d.mode = 2; return d; }
    i -= TP_U;
    { const int e = i >> 6, j = i & 63;
        d.src = p.w_down + (size_t)e * DE * D; d.ld_src = D; d.dst = (u16*)(p.ws + WS_WDN) + (size_t)e * D * DE; d.ld_dst = DE; d.r0 = (j / 8) * 64; d.c0 = (j % 8) * 128; d.mode = 0; return d; }
}
DI void tp_load(const TpDesc& d, f32x4 (&v)[4]) {
    const int sub = threadIdx.x >> 8, t = threadIdx.x & 255;
#pragma unroll
    for (int i = 0; i < 4; ++i) {
        const int row = (t >> 4) + 16 * i, c4 = (t & 15) * 4;
        v[i] = __builtin_nontemporal_load((const f32x4*)(d.src + (size_t)(d.r0 + row) * d.ld_src + d.c0 + sub * 64 + c4));
    }
}
DI void tp_to_lds(float* lt, const f32x4 (&v)[4]) {
    const int sub = threadIdx.x >> 8, t = threadIdx.x & 255;
    lt += sub * 64 * 65;
#pragma unroll
    for (int i = 0; i < 4; ++i) {
        const int row = (t >> 4) + 16 * i, c4 = (t & 15) * 4;
        lt[row * 65 + c4 + 0] = v[i][0]; lt[row * 65 + c4 + 1] = v[i][1]; lt[row * 65 + c4 + 2] = v[i][2]; lt[row * 65 + c4 + 3] = v[i][3];
    }
}
DI void tp_store(const float* lt, const TpDesc& d) {
    const int sub = threadIdx.x >> 8, t = threadIdx.x & 255;
    lt += sub * 64 * 65;
    const int c = t >> 2, rc = (t & 3) * 16;
    const int cg_ = d.c0 + sub * 64 + c;
    int drow = cg_;
    if (d.mode == 1) drow = (cg_ >> 7) * 256 + (cg_ & 127);
    else if (d.mode == 2) drow = (cg_ >> 7) * 256 + (cg_ & 127) + 128;
    unsigned pk[8];
#pragma unroll
    for (int e = 0; e < 8; ++e) pk[e] = pack2(lt[(rc + 2 * e) * 65 + c], lt[(rc + 2 * e + 1) * 65 + c]);
    uint4* dp = (uint4*)(d.dst + (size_t)drow * d.ld_dst + d.r0 + rc);
    dp[0] = make_uint4(pk[0], pk[1], pk[2], pk[3]);
    dp[1] = make_uint4(pk[4], pk[5], pk[6], pk[7]);
}

DI void phase0(const Params& p, char* lds) {
    float* lt = (float*)lds;
    const int t = threadIdx.x;
    constexpr int I_MOD = 192, I_WPC = 64, I_MISC = 1;
    for (int it = blockIdx.x; it < I_MOD + I_WPC + I_MISC; it += gridDim.x) {
        int i = it;
        if (i < I_MOD) {
            const int cc = i % 12, kc = i / 12;
            const int col = cc * 512 + t;
            float* lsil = (float*)lds;
            __syncthreads();
            if (t < 128) { const int k = kc * 64 + (t & 63); lsil[t] = siluf_((t < 64) ? p.c[k] : p.c_ctx[k]); }
            __syncthreads();
            float a0 = 0.f, a1 = 0.f;
#pragma unroll
            for (int kb = 0; kb < 4; ++kb) {
                float wv[16];
#pragma unroll
                for (int j = 0; j < 16; ++j) wv[j] = __builtin_nontemporal_load(p.w_mod + (size_t)(kc * 64 + kb * 16 + j) * 6144 + col);
#pragma unroll
                for (int j = 0; j < 16; ++j) { a0 += lsil[kb * 16 + j] * wv[j]; a1 += lsil[64 + kb * 16 + j] * wv[j]; }
            }
            if (kc == 0) { const float b = p.b_mod[col]; a0 += b; a1 += b; }
            float* modp = (float*)(p.ws + WS_MODP);
            modp[(kc * 2 + 0) * 6144 + col] = a0;
            modp[(kc * 2 + 1) * 6144 + col] = a1;
            asm volatile("s_waitcnt vmcnt(0)" ::: "memory");
            __syncthreads();
            if (t == 0) {
                __builtin_amdgcn_fence(__ATOMIC_RELEASE, "agent");
                asm volatile("s_waitcnt vmcnt(0)" ::: "memory");
                (void)__hip_atomic_fetch_add((unsigned*)(p.ws + WS_BAR) + 96, 1u, __ATOMIC_RELAXED, __HIP_MEMORY_SCOPE_AGENT);
            }
            continue;
        }
        i -= I_MOD;
        if (i < I_WPC) {
            const int o0 = (i / 4) * 64, g = i % 4;
            float* lw = (float*)lds;
            __syncthreads();
            for (int e = t; e < 128 * 128; e += NTH) lw[e] = p.w_pool_grp[(size_t)g * 16384 + e] * p.pool_scale[g * 128 + (e & 127)];
            __syncthreads();
            const int o = o0 + (t & 63);
            const int iw = (t >> 6) * 16;
            float a[16];
#pragma unroll
            for (int e = 0; e < 16; ++e) a[e] = 0.f;
            for (int jb = 0; jb < 128; jb += 8) {
                float wp[8];
#pragma unroll
                for (int q = 0; q < 8; ++q) wp[q] = p.w_pool_proj[(size_t)(g * 128 + jb + q) * D + o];
#pragma unroll
                for (int e = 0; e < 16; ++e) {
                    const float4 l0 = *(const float4*)(lw + (iw + e) * 128 + jb), l1 = *(const float4*)(lw + (iw + e) * 128 + jb + 4);
                    a[e] += l0.x * wp[0] + l0.y * wp[1] + l0.z * wp[2] + l0.w * wp[3] + l1.x * wp[4] + l1.y * wp[5] + l1.z * wp[6] + l1.w * wp[7];
                }
            }
            unsigned pk[8];
#pragma unroll
            for (int e = 0; e < 8; ++e) pk[e] = pack2(a[2 * e], a[2 * e + 1]);
            uint4* dp = (uint4*)((u16*)(p.ws + WS_WPC) + (size_t)o * ATT + g * 128 + iw);
            dp[0] = make_uint4(pk[0], pk[1], pk[2], pk[3]);
            dp[1] = make_uint4(pk[4], pk[5], pk[6], pk[7]);
            continue;
        }
        {
            float* wrt = (float*)(p.ws + WS_WRT);
#pragma unroll
            for (int kk = 0; kk < 2; ++kk) {
                const int k = t + kk * NTH;
                const float4 rg = *(const float4*)(p.w_rg + (size_t)k * 4);
                float4 re[8];
#pragma unroll
                for (int q = 0; q < 8; ++q) re[q] = *(const float4*)(p.w_re + (size_t)k * 32 + q * 4);
                wrt[0 * 1024 + k] = rg.x; wrt[1 * 1024 + k] = rg.y; wrt[2 * 1024 + k] = rg.z; wrt[3 * 1024 + k] = rg.w;
#pragma unroll
                for (int q = 0; q < 8; ++q) {
                    wrt[(4 + q * 4 + 0) * 1024 + k] = re[q].x; wrt[(4 + q * 4 + 1) * 1024 + k] = re[q].y;
                    wrt[(4 + q * 4 + 2) * 1024 + k] = re[q].z; wrt[(4 + q * 4 + 3) * 1024 + k] = re[q].w;
                }
            }
            if (t < 33) ((int*)(p.ws + WS_CNT))[t * 64] = 0;
        }
    }
    __syncthreads();
    {
        constexpr int TP_P0 = TP_TOTAL - TP_DN;
        unsigned* qhead = (unsigned*)(p.ws + WS_BAR) + 64;
        int* lq = (int*)(lds + 4 * 64 * 65 * 4);
        float* lt0 = lt; float* lt1 = lt + 2 * 64 * 65;
        __syncthreads();
        if (t == 0) lq[0] = (int)atomicAdd(qhead, 2u);
        __syncthreads();
        int ia = lq[0];
        if (ia < TP_P0) {
            TpDesc da = tp_decode(p, ia), db = tp_decode(p, ia + 1);
            f32x4 ra[4], rb[4];
            tp_load(da, ra); tp_load(db, rb);
            for (;;) {
                __syncthreads();
                if (t == 0) lq[0] = (int)atomicAdd(qhead, 2u);
                tp_to_lds(lt0, ra); tp_to_lds(lt1, rb);
                __syncthreads();
                const TpDesc ca = da, cb = db;
                const int na = lq[0];
                const bool more = na < TP_P0;
                da = tp_decode(p, more ? na : ia); db = tp_decode(p, more ? na + 1 : ia);
                tp_load(da, ra); tp_load(db, rb);
                tp_store(lt0, ca); tp_store(lt1, cb);
                if (!more) break;
                ia = na;
            }
        }
        __syncthreads();
    }
}

DI void load_modvec(float* dst, const Params& p, int cond, int vec) {
    const float* modp = (const float*)(p.ws + WS_MODP);
    for (int i = threadIdx.x; i < 1024; i += NTH) {
        float s = 0.f;
#pragma unroll
        for (int kc = 0; kc < 16; ++kc) s += modp[(kc * 2 + cond) * 6144 + vec * 1024 + i];
        dst[i] = s;
    }
}

template <int NB>
DI void ln_rows(float4 (&v)[NB][4], const float* g, const float* b, int lane) {
    float mu[NB], rstd[NB];
#pragma unroll
    for (int r = 0; r < NB; ++r) {
        float s = 0.f;
#pragma unroll
        for (int j = 0; j < 4; ++j) s += v[r][j].x + v[r][j].y + v[r][j].z + v[r][j].w;
        mu[r] = s;
    }
#pragma unroll
    for (int r = 0; r < NB; ++r) mu[r] = wave_sum(mu[r]) * (1.f / 1024.f);
#pragma unroll
    for (int r = 0; r < NB; ++r) {
        float q = 0.f;
#pragma unroll
        for (int j = 0; j < 4; ++j) {
            v[r][j].x -= mu[r]; v[r][j].y -= mu[r]; v[r][j].z -= mu[r]; v[r][j].w -= mu[r];
            q += v[r][j].x * v[r][j].x + v[r][j].y * v[r][j].y + v[r][j].z * v[r][j].z + v[r][j].w * v[r][j].w;
        }
        rstd[r] = q;
    }
#pragma unroll
    for (int r = 0; r < NB; ++r) rstd[r] = rsqrtf(wave_sum(rstd[r]) * (1.f / 1024.f) + LN_EPS);
#pragma unroll
    for (int j = 0; j < 4; ++j) {
        const float4 gg = *(const float4*)(g + (j * 64 + lane) * 4);
        const float4 bb = *(const float4*)(b + (j * 64 + lane) * 4);
#pragma unroll
        for (int r = 0; r < NB; ++r) {
            v[r][j].x = v[r][j].x * rstd[r] * gg.x + bb.x; v[r][j].y = v[r][j].y * rstd[r] * gg.y + bb.y;
            v[r][j].z = v[r][j].z * rstd[r] * gg.z + bb.z; v[r][j].w = v[r][j].w * rstd[r] * gg.w + bb.w;
        }
    }
}

DI void phase1(const Params& p, char* lds) {
    if (threadIdx.x == 0) {
        unsigned* mc = (unsigned*)(p.ws + WS_BAR) + 96;
        unsigned sp = 0;
        while (__hip_atomic_load(mc, __ATOMIC_RELAXED, __HIP_MEMORY_SCOPE_AGENT) < 192u) { __builtin_amdgcn_s_sleep(1); if (++sp > (1u << 22)) break; }
        __builtin_amdgcn_fence(__ATOMIC_ACQUIRE, "agent");
        asm volatile("s_waitcnt vmcnt(0)" ::: "memory");
    }
    __syncthreads();
    float* lm = (float*)lds;
    load_modvec(lm + 0, p, 0, 0); load_modvec(lm + 1024, p, 0, 1);
    load_modvec(lm + 2048, p, 1, 0); load_modvec(lm + 3072, p, 1, 1);
    __syncthreads();
    const int lane = threadIdx.x & 63, w = threadIdx.x >> 6;
    u16* hm = (u16*)(p.ws + WS_HM);
    for (int row0 = (blockIdx.x * NWV + w) * 4; row0 < MT; row0 += gridDim.x * NWV * 4) {
        const float* src = (row0 < L) ? (p.x + (size_t)row0 * D) : (p.ctx + (size_t)(row0 - L) * D);
        const float* sh = lm + ((row0 < L) ? 0 : 2048);
        const float* sc = sh + 1024;
        float4 v[4][4];
#pragma unroll
        for (int r = 0; r < 4; ++r)
#pragma unroll
            for (int j = 0; j < 4; ++j) { const f32x4 xv = __builtin_nontemporal_load((const f32x4*)(src + (size_t)r * D + (j * 64 + lane) * 4)); v[r][j] = make_float4(xv[0], xv[1], xv[2], xv[3]); }
        ln_rows<4>(v, p.ln_in_g, p.ln_in_b, lane);
#pragma unroll
        for (int j = 0; j < 4; ++j) {
            const int e = (j * 64 + lane) * 4;
            const float4 s4 = *(const float4*)(sh + e), c4 = *(const float4*)(sc + e);
#pragma unroll
            for (int r = 0; r < 4; ++r) {
                const float m0 = v[r][j].x * (1.f + c4.x) + s4.x, m1 = v[r][j].y * (1.f + c4.y) + s4.y;
                const float m2 = v[r][j].z * (1.f + c4.z) + s4.z, m3 = v[r][j].w * (1.f + c4.w) + s4.w;
                *(uint2*)(hm + (size_t)(row0 + r) * D + e) = make_uint2(pack2(m0, m1), pack2(m2, m3));
            }
        }
    }
}

struct EpiP2 {
    static constexpr bool PERM = true;
    unsigned char* ws;
    DI void operator()(const f32x4 (&acc)[2][2][4][2], const pg::Unit& u, int wr, int wc, int fr, int fq) const {
        const int row0 = u.pm * 256 + wr * 64 + fr;
        const int cu = u.pn * 256;
        const int cl = wc * 32 + 8 * fq;
        if (cu >= 1024 && cu < 1536) {
            u16* VT = (u16*)(ws + WS_VT);
#pragma unroll
            for (int ai = 0; ai < 2; ++ai)
#pragma unroll
                for (int m = 0; m < 4; ++m)
#pragma unroll
                    for (int bj = 0; bj < 2; ++bj) {
                        u16* vp = VT + (size_t)(cu - 1024 + bj * 128 + cl) * MT + row0 + ai * 128 + m * 16;
                        const f32x4 v0 = acc[ai][bj][m][0], v1 = acc[ai][bj][m][1];
#pragma unroll
                        for (int j = 0; j < 4; ++j) { vp[(size_t)j * MT] = f2bf(v0[j]); vp[(size_t)(4 + j) * MT] = f2bf(v1[j]); }
                    }
            return;
        }
        u16* base; int ld; float sc = 1.f;
        if (cu < 512) { base = (u16*)(ws + WS_Q) + cu; ld = ATT; sc = 0.125f * 1.44269504089f; }
        else if (cu < 1024) { base = (u16*)(ws + WS_K) + (cu - 512); ld = ATT; }
        else if (cu < 2048) { base = (u16*)(ws + WS_POOL) + (cu - 1536); ld = ATT; }
        else if (cu < 3072) { base = (u16*)(ws + WS_SA) + (cu - 2048); ld = D; }
        else { base = (u16*)(ws + WS_SB) + (cu - 3072); ld = D; }
        base += (size_t)row0 * ld + cl;
        if (cu < 2048) {
#pragma unroll
            for (int ai = 0; ai < 2; ++ai)
#pragma unroll
                for (int m = 0; m < 4; ++m)
#pragma unroll
                    for (int bj = 0; bj < 2; ++bj)
                        *(u32x4*)(base + (size_t)(ai * 128 + m * 16) * ld + bj * 128) = pack8v(acc[ai][bj][m][0] * sc, acc[ai][bj][m][1] * sc);
        } else {
#pragma unroll
            for (int ai = 0; ai < 2; ++ai)
#pragma unroll
                for (int m = 0; m < 4; ++m)
#pragma unroll
                    for (int bj = 0; bj < 2; ++bj) {
                        f32x4 v0 = acc[ai][bj][m][0], v1 = acc[ai][bj][m][1];
#pragma unroll
                        for (int j = 0; j < 4; ++j) { v0[j] = sigmoidf_(v0[j]); v1[j] = sigmoidf_(v1[j]); }
                        __builtin_nontemporal_store(pack8v(v0, v1), (u32x4*)(base + (size_t)(ai * 128 + m * 16) * D + bj * 128));
                    }
        }
    }
};

DI void ctx_kv_item(const Params& p, int item, char* lds) {
    const int t = threadIdx.x, lane = t & 63, w = t >> 6, lr = lane & 31, lh = lane >> 5;
    const int rb = item >> 5, cb = item & 31;
    const u16* hm = (const u16*)(p.ws + WS_HM); const u16* wt = (const u16*)(p.ws + WS_WIN);
    const u16* ap = hm + (size_t)(L + rb * 32 + lr) * D + w * 128 + 8 * lh;
    const u16* bp = wt + (size_t)(512 + cb * 32 + lr) * D + w * 128 + 8 * lh;
    f32x16 acc;
#pragma unroll
    for (int i = 0; i < 16; ++i) acc[i] = 0.f;
#pragma unroll
    for (int ks = 0; ks < 8; ++ks) {
        const bf16x8 a = *(const bf16x8*)(ap + ks * 16), b = *(const bf16x8*)(bp + ks * 16);
        acc = MFMA(a, b, acc);
    }
    float* part = (float*)lds;
    __syncthreads();
#pragma unroll
    for (int i = 0; i < 16; ++i) part[(w * 32 + (i & 3) + 8 * (i >> 2) + 4 * lh) * 33 + lr] = acc[i];
    __syncthreads();
    const int row = t >> 4, c = (t & 15) * 2;
    float s0 = 0.f, s1 = 0.f;
#pragma unroll
    for (int ww = 0; ww < 8; ++ww) { s0 += part[(ww * 32 + row) * 33 + c]; s1 += part[(ww * 32 + row) * 33 + c + 1]; }
    const int grow = L + rb * 32 + row;
    if (cb < 16) {
        *(unsigned*)((u16*)(p.ws + WS_K) + (size_t)grow * ATT + cb * 32 + c) = pack2(s0, s1);
    } else {
        u16* VT = (u16*)(p.ws + WS_VT);
        VT[(size_t)((cb - 16) * 32 + c) * MT + grow] = f2bf(s0);
        VT[(size_t)((cb - 16) * 32 + c + 1) * MT + grow] = f2bf(s1);
    }
}

DI void phase2(const Params& p, char* lds) {
    pg::DenseSched S; S.init(p.ws + WS_HM, p.ws + WS_WIN, L, PROJ, D);
    EpiP2 E{p.ws};
    pg::gemm_phase(( LAS unsigned char*)lds, D, S, E);
    for (int it = blockIdx.x; it < 256; it += gridDim.x) ctx_kv_item(p, it, lds);
}

DI bf16x8 pack8(float a0, float a1, float a2, float a3, float a4, float a5, float a6, float a7) {
    uint4 u = make_uint4(pack2(a0, a1), pack2(a2, a3), pack2(a4, a5), pack2(a6, a7));
    return __builtin_bit_cast(bf16x8, u);
}

constexpr int LROW = 144;
constexpr int VROW = 272;
constexpr int ATT_LK = 0, ATT_LV = 4 * 128 * LROW, ATT_LB = ATT_LV + 4 * 64 * VROW;

DI void attn_item_rh(int item, int& r, int& hq) {
    if (gridDim.x == 256) { const int c = item & 255; hq = item >> 8; r = 32 * (c & 7) + (c >> 3); }
    else { r = item >> 1; hq = item & 1; }
}
DI void attn_load(const Params& p, int item, int st, u32x4 (&rk)[8], u32x4 (&rv)[8]) {
    const int t = threadIdx.x;
    int r, hq; attn_item_rh(item, r, hq);
    const int rs = min(max(r - 4, 0), 256 - 8);
    const int tokbase = (st < 2) ? (L + st * 128) : ((rs + 2 * (st - 2)) * 64);
    const u16* Kb = (const u16*)(p.ws + WS_K); const u16* VT = (const u16*)(p.ws + WS_VT);
#pragma unroll
    for (int i = 0; i < 8; ++i) {
        const int c = t + NTH * i, hh = c >> 10, key = (c >> 3) & 127, ch = c & 7;
        rk[i] = *(const u32x4*)(Kb + (size_t)(tokbase + key) * ATT + (hq * 4 + hh) * 64 + ch * 8);
    }
#pragma unroll
    for (int i = 0; i < 8; ++i) {
        const int c = t + NTH * i, hh = c >> 10, d = (c >> 4) & 63, ch = c & 15;
        rv[i] = *(const u32x4*)(VT + (size_t)((hq * 4 + hh) * 64 + d) * MT + tokbase + ch * 8);
    }
}
DI void attn_store_lds(char* lds, const u32x4 (&rk)[8], const u32x4 (&rv)[8]) {
    const int t = threadIdx.x;
    char* lk = lds + ATT_LK; char* lv = lds + ATT_LV;
#pragma unroll
    for (int i = 0; i < 8; ++i) {
        const int c = t + NTH * i, hh = c >> 10, key = (c >> 3) & 127, ch = c & 7;
        *(u32x4*)(lk + (hh * 128 + key) * LROW + ch * 16) = rk[i];
    }
#pragma unroll
    for (int i = 0; i < 8; ++i) {
        const int c = t + NTH * i, hh = c >> 10, d = (c >> 4) & 63, ch = c & 15;
        char* rowp = lv + (hh * 64 + d) * VROW;
        *(uint2*)(rowp + (16 * (ch >> 1) + 4 * (ch & 1)) * 2) = make_uint2(rv[i].x, rv[i].y);
        *(uint2*)(rowp + (16 * (ch >> 1) + 8 + 4 * (ch & 1)) * 2) = make_uint2(rv[i].z, rv[i].w);
    }
}

template <int KIND>
DI void attn_sub(const char* lkrow, const char* lvrow, int vpos0, int vpos1, const float* btA, const float* btB, int kA, int kB,
                 int qc, int cs, int lh, const bf16x8 (&qf)[4], f32x16& o0, f32x16& o1, float& m, float& lsum) {
    f32x16 s;
#pragma unroll
    for (int i = 0; i < 16; ++i) s[i] = 0.f;
#pragma unroll
    for (int ks = 0; ks < 4; ++ks) {
        const bf16x8 kf = *(const bf16x8*)(lkrow + (ks * 2 + lh) * 16);
        s = MFMA(kf, qf[ks], s);
    }
    if (KIND == 1) {
        const float* pA = btA + (kA + 4 * lh - qc + 15);
        const float* pB = btB + (kB + 4 * lh - qc + 15);
        const int wA = kA + 4 * lh - cs, wB = kB + 4 * lh - cs;
        float bv[16];
#pragma unroll
        for (int i = 0; i < 16; ++i) bv[i] = ((i < 8) ? pA : pB)[(i & 3) + 8 * (i >> 2)];
#pragma unroll
        for (int i = 0; i < 16; ++i) {
            const bool valid = (unsigned)(((i < 8) ? wA : wB) + (i & 3) + 8 * (i >> 2)) < 16u;
            s[i] = valid ? (s[i] + bv[i]) : -1e30f;
        }
    }
    float tmax = s[0];
#pragma unroll
    for (int i = 1; i < 16; ++i) tmax = fmaxf(tmax, s[i]);
    if (!__all(tmax - m <= 8.f)) {
        tmax = fmaxf(tmax, __shfl_xor(tmax, 32));
        const float mnew = fmaxf(m, tmax);
        const float alpha = __builtin_amdgcn_exp2f(m - mnew);
        lsum *= alpha;
        m = mnew;
#pragma unroll
        for (int i = 0; i < 16; ++i) { o0[i] *= alpha; o1[i] *= alpha; }
    }
    float psum = 0.f;
#pragma unroll
    for (int i = 0; i < 16; ++i) { s[i] = __builtin_amdgcn_exp2f(s[i] - m); psum += s[i]; }
    lsum += psum;
#pragma unroll
    for (int j = 0; j < 2; ++j) {
        const bf16x8 pf = pack8(s[8 * j + 0], s[8 * j + 1], s[8 * j + 2], s[8 * j + 3], s[8 * j + 4], s[8 * j + 5], s[8 * j + 6], s[8 * j + 7]);
        const int vp = j ? vpos1 : vpos0;
        const bf16x8 v0 = *(const bf16x8*)(lvrow + (vp + 8 * lh) * 2);
        const bf16x8 v1 = *(const bf16x8*)(lvrow + 32 * VROW + (vp + 8 * lh) * 2);
        o0 = MFMA(v0, pf, o0);
        o1 = MFMA(v1, pf, o1);
    }
}

DI void attn_phase(const Params& p, char* lds) {
    const int t = threadIdx.x, lane = t & 63, w = t >> 6;
    const int hl = w >> 1, qh = w & 1;
    const int lr = lane & 31, lh = lane >> 5;
    const int qc = qh * 32 + lr;
    const int cs = min(max(qc - 8, 0), 48);
    const u16* Q = (const u16*)(p.ws + WS_Q);
    u16* YA = (u16*)(p.ws + WS_YATT);
    const char* lk = lds + ATT_LK; const char* lv = lds + ATT_LV; float* lbias = (float*)(lds + ATT_LB);
    constexpr int N_ATT = 512;
    int item = blockIdx.x;
    if (item >= N_ATT) return;
    u32x4 rk[8], rv[8];
    attn_load(p, item, 0, rk, rv);
    bf16x8 qf[4];
    f32x16 o0, o1;
    float m = -1e30f, lsum = 0.f;
    int st = 0;
    for (;;) {
        int r, hq; attn_item_rh(item, r, hq);
        const int head = hq * 4 + hl, tok = r * 64 + qc;
        const int rs = min(max(r - 4, 0), 256 - 8);
        __syncthreads();
        attn_store_lds(lds, rk, rv);
        if (st == 0) {
            for (int i = t; i < 4 * 465; i += NTH) lbias[i] = p.rpb[hq * 4 * 465 + i] * 1.44269504089f;
#pragma unroll
            for (int ks = 0; ks < 4; ++ks) qf[ks] = *(const bf16x8*)(Q + (size_t)tok * ATT + head * 64 + ks * 16 + lh * 8);
#pragma unroll
            for (int i = 0; i < 16; ++i) { o0[i] = 0.f; o1[i] = 0.f; }
            m = -1e30f; lsum = 0.f;
        }
        __syncthreads();
        int nitem = item, nst = st + 1;
        if (nst == 6) { nst = 0; nitem = item + gridDim.x; }
        const bool more = nitem < N_ATT;
        attn_load(p, more ? nitem : item, more ? nst : st, rk, rv);
        {
            const char* lkh = lk + hl * 128 * LROW;
            const char* lvrow = lv + (hl * 64 + lr) * VROW;
            if (st < 2) {
#pragma unroll 1
                for (int sub = 0; sub < 4; ++sub)
                    attn_sub<0>(lkh + (sub * 32 + lr) * LROW, lvrow, sub * 32, sub * 32 + 16, lbias, lbias, 0, 0, qc, cs, lh, qf, o0, o1, m, lsum);
            } else {
                const int g0 = rs + 2 * (st - 2);
                const float* bt0 = lbias + hl * 465 + (g0 - r + 7) * 31;
                const float* bt1 = bt0 + 31;
                const int fb = qh * 32;
                const int cb = qh ? 16 : 32;
                attn_sub<1>(lkh + (fb + lr) * LROW, lvrow, fb, fb + 16, bt0, bt0, fb, fb, qc, cs, lh, qf, o0, o1, m, lsum);
                attn_sub<1>(lkh + (64 + fb + lr) * LROW, lvrow, 64 + fb, 64 + fb + 16, bt1, bt1, fb, fb, qc, cs, lh, qf, o0, o1, m, lsum);
                attn_sub<1>(lkh + (((lr < 16) ? cb : 48 + cb) + lr) * LROW, lvrow, cb, 64 + cb, bt0, bt1, cb, cb - 16, qc, cs, lh, qf, o0, o1, m, lsum);
            }
        }
        if (st == 5) {
            const float inv = 1.f / (lsum + __shfl_xor(lsum, 32));
#pragma unroll
            for (int q = 0; q < 4; ++q) {
                const int d0 = q * 8 + lh * 4;
                *(uint2*)(YA + (size_t)tok * ATT + head * 64 + d0) =
                    make_uint2(pack2(o0[q * 4] * inv, o0[q * 4 + 1] * inv), pack2(o0[q * 4 + 2] * inv, o0[q * 4 + 3] * inv));
                *(uint2*)(YA + (size_t)tok * ATT + head * 64 + 32 + d0) =
                    make_uint2(pack2(o1[q * 4] * inv, o1[q * 4 + 1] * inv), pack2(o1[q * 4 + 2] * inv, o1[q * 4 + 3] * inv));
            }
        }
        if (!more) break;
        item = nitem; st = nst;
    }
    __syncthreads();
}

DI void pool_item(const Params& p, int pt, char* lds) {
    const int tok0 = pt * 64;
    const u16* PLb = (const u16*)(p.ws + WS_POOL);
    __syncthreads();
    for (int c = threadIdx.x; c < 80 * 64; c += NTH) {
        const int row = c >> 6, ch = c & 63, tt = tok0 - 8 + row;
        u32x4 v = (u32x4){0u, 0u, 0u, 0u};
        if (tt >= 0 && tt < L) v = *(const u32x4*)(PLb + (size_t)tt * ATT + ch * 8);
        *(u32x4*)(lds + row * 1024 + ch * 16) = v;
    }
    __syncthreads();
    const int t = threadIdx.x & 255, th = threadIdx.x >> 8;
    const unsigned* lp = (const unsigned*)lds;
    unsigned* PD = (unsigned*)(p.ws + WS_POOLED);
    const int g = t >> 6;
    const int half = 1 << g;
    const int tl0 = th * 32;
    float s0 = 0.f, s1 = 0.f;
    for (int k = -half; k < half; ++k) { const unsigned u = lp[(tl0 + k + 8) * 256 + t]; s0 += bflo(u); s1 += bfhi(u); }
#pragma unroll 8
    for (int i = 0; i < 32; ++i) {
        const int tl = tl0 + i, tok = tok0 + tl;
        const int lo = max(tok - half, 0), hi = min(tok + half, L);
        const float invn = 1.f / (float)(hi - lo);
        const unsigned u = lp[(tl + 8) * 256 + t];
        PD[(size_t)tok * 256 + t] = pack2(s0 * invn - bflo(u), s1 * invn - bfhi(u));
        const unsigned ua = lp[(tl + half + 8) * 256 + t], ud = lp[(tl - half + 8) * 256 + t];
        s0 += bflo(ua) - bflo(ud); s1 += bfhi(ua) - bfhi(ud);
    }
}

DI void phase3(const Params& p, char* lds) {
    attn_phase(p, lds);
    for (int it = blockIdx.x; it < 256; it += gridDim.x) pool_item(p, it, lds);
}

template <int PASS> struct EpiP4 {
    static constexpr bool PERM = true;
    unsigned char* ws;
    DI void operator()(const f32x4 (&acc)[2][2][4][2], const pg::Unit& u, int wr, int wc, int fr, int fq) const {
        const u16* G = (const u16*)(ws + (PASS == 0 ? WS_SA : WS_SB));
        u16* Z = (u16*)(ws + WS_Z);
        const int row0 = u.pm * 256 + wr * 64 + fr;
#pragma unroll
        for (int ai = 0; ai < 2; ++ai)
#pragma unroll
            for (int m = 0; m < 4; ++m)
#pragma unroll
                for (int bj = 0; bj < 2; ++bj) {
                    const size_t o = (size_t)(row0 + ai * 128 + m * 16) * D + u.pn * 256 + bj * 128 + wc * 32 + 8 * fq;
                    const u32x4 g = __builtin_nontemporal_load((const u32x4*)(G + o));
                    f32x4 v0 = acc[ai][bj][m][0], v1 = acc[ai][bj][m][1];
                    v0[0] *= bflo(g.x); v0[1] *= bfhi(g.x); v0[2] *= bflo(g.y); v0[3] *= bfhi(g.y);
                    v1[0] *= bflo(g.z); v1[1] *= bfhi(g.z); v1[2] *= bflo(g.w); v1[3] *= bfhi(g.w);
                    if (PASS == 1) {
                        const u32x4 z = *(const u32x4*)(Z + o);
                        v0[0] += bflo(z.x); v0[1] += bfhi(z.x); v0[2] += bflo(z.y); v0[3] += bfhi(z.y);
                        v1[0] += bflo(z.z); v1[1] += bfhi(z.z); v1[2] += bflo(z.w); v1[3] += bfhi(z.w);
                    }
                    *(u32x4*)(Z + o) = pack8v(v0, v1);
                }
    }
};

DI void phase4(const Params& p, char* lds) {
    { pg::DenseSched S; S.init(p.ws + WS_YATT, p.ws + WS_WA, L, D, ATT); EpiP4<0> E{p.ws}; pg::gemm_phase((LAS unsigned char*)lds, ATT, S, E); }
    { pg::DenseSched S; S.init(p.ws + WS_POOLED, p.ws + WS_WPC, L, D, ATT); EpiP4<1> E{p.ws}; pg::gemm_phase((LAS unsigned char*)lds, ATT, S, E); }
}

struct EpiP5 {
    static constexpr bool PERM = true;
    DI bool keep(const pg::Unit&) const { return false; }
    u16* Y;
    DI void operator()(f32x4 (&acc)[2][2][4][2], const pg::Unit& u, int wr, int wc, int fr, int fq) const {
        const int row0 = u.pm * 256 + wr * 64 + fr, col0 = u.pn * 256 + wc * 32 + 8 * fq;
#pragma unroll
        for (int ai = 0; ai < 2; ++ai)
#pragma unroll
            for (int m = 0; m < 4; ++m) {
                u16* rowp = Y + (size_t)(row0 + ai * 128 + m * 16) * D + col0;
#pragma unroll
                for (int bj = 0; bj < 2; ++bj) *(u32x4*)(rowp + bj * 128) = pack8v(acc[ai][bj][m][0], acc[ai][bj][m][1]);
            }
    }
};

DI void phase5(const Params& p, char* lds) {
    pg::DenseSched S; S.init(p.ws + WS_Z, p.ws + WS_WOUT, L, D, D);
    EpiP5 E{(u16*)(p.ws + WS_HM2)};
    pg::gemm_phase((LAS unsigned char*)lds, D, S, E);
    {
        const int zr[2] = {0, 0};
        for (int i = 0;; ++i) {
            pg::Unit u;
            if (!S.next(i, u, zr, zr)) break;
            if (threadIdx.x == 0) {
                __builtin_amdgcn_fence(__ATOMIC_RELEASE, "agent");
                asm volatile("s_waitcnt vmcnt(0)" ::: "memory");
                (void)__hip_atomic_fetch_add((unsigned*)(p.ws + WS_BAR) + u.pm, 1u, __ATOMIC_RELAXED, __HIP_MEMORY_SCOPE_AGENT);
            }
        }
    }
}

DI void phase6(const Params& p, char* lds) {
    float* lm = (float*)lds;
    load_modvec(lm, p, 0, 2); load_modvec(lm + 1024, p, 0, 3); load_modvec(lm + 2048, p, 0, 4);
    __syncthreads();
    const int lane = threadIdx.x & 63, w = threadIdx.x >> 6;
    float* Y = (float*)(p.ws + WS_Y);
    u16* HM2 = (u16*)(p.ws + WS_HM2);
    const float* wrt = (const float*)(p.ws + WS_WRT);
    int* cnt = (int*)(p.ws + WS_CNT); int* list = (int*)(p.ws + WS_LIST); float* cw = (float*)(p.ws + WS_CW);
    int4* tinfo = (int4*)(p.ws + WS_TINFO);
    int* lcnt = (int*)(lds + 12288); int* lbase = lcnt + 32; int* recE = lbase + 32; int* recP = recE + 128; float* recC = (float*)(recP + 128);
    float* lwre = (float*)(lds + 16384);
    for (int i = threadIdx.x; i < 32 * 256; i += NTH) *(float4*)(lwre + i * 4) = *(const float4*)(wrt + 4 * 1024 + i * 4);
    for (int tb = blockIdx.x; tb < L / 64; tb += gridDim.x) {
    if (threadIdx.x == 0) {
        unsigned* pc = (unsigned*)(p.ws + WS_BAR) + (tb >> 2);
        unsigned sp = 0;
        while (__hip_atomic_load(pc, __ATOMIC_RELAXED, __HIP_MEMORY_SCOPE_AGENT) < 4u) { __builtin_amdgcn_s_sleep(1); if (++sp > (1u << 22)) break; }
        __builtin_amdgcn_fence(__ATOMIC_ACQUIRE, "agent");
        asm volatile("s_waitcnt vmcnt(0)" ::: "memory");
    }
    __syncthreads();
    if (threadIdx.x < 32) lcnt[threadIdx.x] = 0;
    __syncthreads();
    for (int tp = 0; tp < 4; ++tp) {
        constexpr int NB = 2;
        const int tl0 = w * 8 + tp * NB, row0 = tb * 64 + tl0;
        float4 v[NB][4], y[NB][4];
#pragma unroll
        for (int r = 0; r < NB; ++r)
#pragma unroll
            for (int j = 0; j < 4; ++j) {
                { const f32x4 xv = __builtin_nontemporal_load((const f32x4*)(p.x + (size_t)(row0 + r) * D + (j * 64 + lane) * 4)); v[r][j] = make_float4(xv[0], xv[1], xv[2], xv[3]); }
                { const u32x2 ybv = __builtin_nontemporal_load((const u32x2*)(HM2 + (size_t)(row0 + r) * D + (j * 64 + lane) * 4)); const uint2 yb = make_uint2(ybv[0], ybv[1]);
                  y[r][j] = make_float4(bflo(yb.x), bfhi(yb.x), bflo(yb.y), bfhi(yb.y)); }
            }
        ln_rows<NB>(v, p.ln_in_g, p.ln_in_b, lane);
#pragma unroll
        for (int j = 0; j < 4; ++j) {
            const float4 g1 = *(const float4*)(lm + (j * 64 + lane) * 4);
#pragma unroll
            for (int r = 0; r < NB; ++r) {
                v[r][j].x = ALPHA * v[r][j].x + g1.x * y[r][j].x; v[r][j].y = ALPHA * v[r][j].y + g1.y * y[r][j].y;
                v[r][j].z = ALPHA * v[r][j].z + g1.z * y[r][j].z; v[r][j].w = ALPHA * v[r][j].w + g1.w * y[r][j].w;
            }
        }
        ln_rows<NB>(v, p.ln1_g, p.ln1_b, lane);
#pragma unroll
        for (int j = 0; j < 4; ++j) {
            const int e = (j * 64 + lane) * 4;
            const float4 s4 = *(const float4*)(lm + 1024 + e), c4 = *(const float4*)(lm + 2048 + e);
#pragma unroll
            for (int r = 0; r < NB; ++r) {
                { const f32x4 hv = {v[r][j].x, v[r][j].y, v[r][j].z, v[r][j].w}; __builtin_nontemporal_store(hv, (f32x4*)(Y + (size_t)(row0 + r) * D + e)); }
                v[r][j].x = v[r][j].x * (1.f + c4.x) + s4.x; v[r][j].y = v[r][j].y * (1.f + c4.y) + s4.y;
                v[r][j].z = v[r][j].z * (1.f + c4.z) + s4.z; v[r][j].w = v[r][j].w * (1.f + c4.w) + s4.w;
                *(uint2*)(HM2 + (size_t)(row0 + r) * D + e) = make_uint2(pack2(v[r][j].x, v[r][j].y), pack2(v[r][j].z, v[r][j].w));
            }
        }
        const bool h5 = lane & 32, h4 = lane & 16, h3 = lane & 8;
        float cg[NB];
#pragma unroll
        for (int r = 0; r < NB; ++r) {
            float sp[4];
#pragma unroll
            for (int g = 0; g < 4; ++g) sp[g] = 0.f;
#pragma unroll
            for (int j = 0; j < 4; ++j)
#pragma unroll
                for (int g = 0; g < 4; ++g) {
                    const float4 wv = *(const float4*)(wrt + g * 1024 + (j * 64 + lane) * 4);
                    sp[g] += v[r][j].x * wv.x + v[r][j].y * wv.y + v[r][j].z * wv.z + v[r][j].w * wv.w;
                }
            const float a0 = (h5 ? sp[2] : sp[0]) + __shfl_xor(h5 ? sp[0] : sp[2], 32);
            const float a1 = (h5 ? sp[3] : sp[1]) + __shfl_xor(h5 ? sp[1] : sp[3], 32);
            cg[r] = (h4 ? a1 : a0) + __shfl_xor(h4 ? a0 : a1, 16);
        }
        int gsel[NB]; float pg[NB];
#pragma unroll
        for (int r = 0; r < NB; ++r) {
            const float c = row_sum16(cg[r]);
            float lg[4];
#pragma unroll
            for (int g = 0; g < 4; ++g) lg[g] = rl(c, 16 * g) + p.b_rg[g];
            int gs = 0; float gmax = lg[0];
#pragma unroll
            for (int g = 1; g < 4; ++g) if (lg[g] > gmax) { gmax = lg[g]; gs = g; }
            float gden = 0.f;
#pragma unroll
            for (int g = 0; g < 4; ++g) gden += __expf(lg[g] - gmax);
            gsel[r] = gs; pg[r] = 1.f / gden;
        }
        float ce[NB];
#pragma unroll
        for (int r = 0; r < NB; ++r) {
            float sp[8];
            const float* wp0 = lwre + gsel[r] * 8 * 1024;
#pragma unroll
            for (int e = 0; e < 8; ++e) {
                float s_ = 0.f;
#pragma unroll
                for (int j = 0; j < 4; ++j) {
                    const float4 wv = *(const float4*)(wp0 + e * 1024 + (j * 64 + lane) * 4);
                    s_ += v[r][j].x * wv.x + v[r][j].y * wv.y + v[r][j].z * wv.z + v[r][j].w * wv.w;
                }
                sp[e] = s_;
            }
            float a[4];
#pragma unroll
            for (int i = 0; i < 4; ++i) a[i] = (h5 ? sp[4 + i] : sp[i]) + __shfl_xor(h5 ? sp[i] : sp[4 + i], 32);
            const float b0 = (h4 ? a[2] : a[0]) + __shfl_xor(h4 ? a[0] : a[2], 16);
            const float b1 = (h4 ? a[3] : a[1]) + __shfl_xor(h4 ? a[1] : a[3], 16);
            float c = (h3 ? b1 : b0) + dpp_f<0x140>(h3 ? b0 : b1);
            c += dpp_f<0xB1>(c); c += dpp_f<0x4E>(c); c += dpp_f<0x141>(c);
            ce[r] = c;
        }
#pragma unroll
        for (int r = 0; r < NB; ++r) {
            float le[8];
#pragma unroll
            for (int e = 0; e < 8; ++e) le[e] = rl(ce[r], (e >> 2) * 32 + ((e >> 1) & 1) * 16 + (e & 1) * 8) + p.b_re[gsel[r] * 8 + e];
            int e1 = 0; float l1 = le[0];
#pragma unroll
            for (int e = 1; e < 8; ++e) if (le[e] > l1) { l1 = le[e]; e1 = e; }
            int e2 = -1; float l2 = -3.0e38f;
#pragma unroll
            for (int e = 0; e < 8; ++e) if (e != e1 && le[e] > l2) { l2 = le[e]; e2 = e; }
            const float ex = __expf(l2 - l1);
            const float c1 = pg[r] / (1.f + ex), c2 = pg[r] * ex / (1.f + ex);
            if (lane == 0) {
                const int tl = tl0 + r;
                const int E1 = gsel[r] * 8 + e1, E2 = gsel[r] * 8 + e2;
                recE[tl * 2] = E1; recE[tl * 2 + 1] = E2;
                recP[tl * 2] = atomicAdd(&lcnt[E1], 1); recP[tl * 2 + 1] = atomicAdd(&lcnt[E2], 1);
                recC[tl * 2] = c1; recC[tl * 2 + 1] = c2;
            }
        }
    }
    __syncthreads();
    if (threadIdx.x < 32) { const int n = lcnt[threadIdx.x]; lbase[threadIdx.x] = n ? atomicAdd(&cnt[threadIdx.x * 64], n) : 0; }
    __syncthreads();
    if (threadIdx.x < 64) {
        const int tl = threadIdx.x, row = tb * 64 + tl;
        const int E1 = recE[tl * 2], E2 = recE[tl * 2 + 1];
        const int p1 = lbase[E1] + recP[tl * 2], p2 = lbase[E2] + recP[tl * 2 + 1];
        list[E1 * CAP + p1] = row; cw[E1 * CAP + p1] = recC[tl * 2];
        list[E2 * CAP + p2] = row; cw[E2 * CAP + p2] = recC[tl * 2 + 1];
        tinfo[row] = make_int4(E1, p1, E2, p2);
    }
    }
}

DI void build_offsets(const Params& p, int* loff, int* ltoff) {
    const int* cnt = (const int*)(p.ws + WS_CNT);
    int* lc = ltoff + 40;
    __syncthreads();
    if (threadIdx.x < NE) lc[threadIdx.x] = cnt[threadIdx.x * 64];
    __syncthreads();
    if (threadIdx.x == 0) {
        int o = 0, to = 0;
        for (int e = 0; e < NE; ++e) { loff[e] = o; ltoff[e] = to; const int c = lc[e]; o += c; to += (c + 255) >> 8; }
        loff[NE] = o; ltoff[NE] = to;
    }
    __syncthreads();
}

struct MoeSched {
    const char* A; const char* W; size_t wstride; int K, mode;
    const int* cnt; const int* list; const int* loff; const int* ltoff;
    int G, c, nunits;
    DI bool next(int i, pg::Unit& u, const int (&R)[2], const int (&C)[2]) const {
        int e, tl, pn;
        if (G == 256) {
            int j = i * 32 + (c >> 3), q = 0;
            e = c & 7;
            for (; q < 4; ++q) {
                const int nu = __builtin_amdgcn_readfirstlane((ltoff[e + 1] - ltoff[e]) * 4);
                if (j < nu) break;
                j -= nu; e += 8;
            }
            if (q == 4) return false;
            tl = j >> 2; pn = j & 3;
        } else {
            const int Lx = i * G + c; if (Lx >= nunits) return false;
            const int gt = Lx >> 2; pn = Lx & 3;
            e = 0;
            while (e < NE - 1 && ltoff[e + 1] <= gt) ++e;
            tl = gt - ltoff[e];
        }
        u.e = e; u.tl = tl; u.cnt = cnt[e * 64]; u.pm = u.tl; u.pn = pn;
        u.A = A; u.B = W + (size_t)e * wstride + (size_t)pn * 256 * K * 2;
#pragma unroll
        for (int h = 0; h < 2; ++h)
#pragma unroll
            for (int j = 0; j < 2; ++j) {
                int idx = u.tl * 256 + h * 128 + R[j];
                if (idx >= u.cnt) idx = u.cnt - 1;
                const int row = (mode == 0) ? list[e * CAP + idx] : (loff[e] + idx);
                u.ao[h][j] = (unsigned)(row * K + C[j]) * 2u;
            }
        return true;
    }
};

struct EpiP7 {
    static constexpr bool PERM = true;
    unsigned char* ws; const int* loff;
    template <bool CHECK>
    DI void body(const f32x4 (&acc)[2][2][4][2], const pg::Unit& u, int wr, int wc, int fr, int fq) const {
        const int idx0 = u.tl * 256 + wr * 64 + fr;
        const float* cw = (const float*)(ws + WS_CW) + (size_t)u.e * CAP + idx0;
        u16* ACT = (u16*)(ws + WS_ACT) + (size_t)(loff[u.e] + idx0) * DE + u.pn * 128 + wc * 32 + 8 * fq;
        float cwv[2][4];
#pragma unroll
        for (int ai = 0; ai < 2; ++ai)
#pragma unroll
            for (int m = 0; m < 4; ++m) cwv[ai][m] = (!CHECK || idx0 + ai * 128 + m * 16 < u.cnt) ? cw[ai * 128 + m * 16] : 0.f;
#pragma unroll
        for (int ai = 0; ai < 2; ++ai)
#pragma unroll
            for (int m = 0; m < 4; ++m) {
                f32x4 o0, o1;
#pragma unroll
                for (int j = 0; j < 4; ++j) {
                    o0[j] = siluf_(acc[ai][0][m][0][j]) * acc[ai][1][m][0][j] * cwv[ai][m];
                    o1[j] = siluf_(acc[ai][0][m][1][j]) * acc[ai][1][m][1][j] * cwv[ai][m];
                }
                if (!CHECK || idx0 + ai * 128 + m * 16 < u.cnt) *(u32x4*)(ACT + (size_t)(ai * 128 + m * 16) * DE) = pack8v(o0, o1);
            }
    }
    DI void operator()(const f32x4 (&acc)[2][2][4][2], const pg::Unit& u, int wr, int wc, int fr, int fq) const {
        if (u.tl * 256 + 256 <= u.cnt) body<false>(acc, u, wr, wc, fr, fq);
        else body<true>(acc, u, wr, wc, fr, fq);
    }
};

DI void phase7(const Params& p, char* lds) {
    int* loff = (int*)(lds + pg::STAGE_BYTES); int* ltoff = loff + 40;
    build_offsets(p, loff, ltoff);
    MoeSched S; S.A = (const char*)(p.ws + WS_HM2); S.W = (const char*)(p.ws + WS_WGU); S.wstride = (size_t)1024 * D * 2; S.K = D; S.mode = 0;
    S.cnt = (const int*)(p.ws + WS_CNT); S.list = (const int*)(p.ws + WS_LIST); S.loff = loff; S.ltoff = ltoff;
    S.G = gridDim.x; S.c = blockIdx.x; S.nunits = ltoff[NE] * 4;
    EpiP7 E{p.ws, loff};
    pg::gemm_phase((LAS unsigned char*)lds, D, S, E);
    {
        int* qhead = (int*)(p.ws + WS_CNT) + 32 * 64;
        int* lq = ltoff + 80;
        float* lt = (float*)lds; float* lt0 = lt; float* lt1 = lt + 2 * 64 * 65;
        for (;;) {
            __syncthreads();
            if (threadIdx.x == 0) lq[0] = atomicAdd(qhead, 2);
            __syncthreads();
            const int q = lq[0];
            if (q >= TP_DN) break;
            const TpDesc da = tp_decode(p, TP_TOTAL - TP_DN + q), db = tp_decode(p, TP_TOTAL - TP_DN + q + 1);
            f32x4 ra[4], rb[4];
            tp_load(da, ra); tp_load(db, rb);
            tp_to_lds(lt0, ra); tp_to_lds(lt1, rb);
            __syncthreads();
            tp_store(lt0, da); tp_store(lt1, db);
        }
    }
}

struct EpiP8 {
    static constexpr bool PERM = true;
    unsigned char* ws; const int* loff;
    template <bool CHECK>
    DI void body(const f32x4 (&acc)[2][2][4][2], const pg::Unit& u, int wr, int wc, int fr, int fq) const {
        const int idx0 = u.tl * 256 + wr * 64 + fr;
        u16* rowp = (u16*)(ws + WS_OUTP) + (size_t)(loff[u.e] + idx0) * D + u.pn * 256 + wc * 32 + 8 * fq;
#pragma unroll
        for (int ai = 0; ai < 2; ++ai)
#pragma unroll
            for (int m = 0; m < 4; ++m)
                if (!CHECK || idx0 + ai * 128 + m * 16 < u.cnt) {
#pragma unroll
                    for (int bj = 0; bj < 2; ++bj) *(u32x4*)(rowp + (size_t)(ai * 128 + m * 16) * D + bj * 128) = pack8v(acc[ai][bj][m][0], acc[ai][bj][m][1]);
                }
    }
    DI void operator()(const f32x4 (&acc)[2][2][4][2], const pg::Unit& u, int wr, int wc, int fr, int fq) const {
        if (u.tl * 256 + 256 <= u.cnt) body<false>(acc, u, wr, wc, fr, fq);
        else body<true>(acc, u, wr, wc, fr, fq);
    }
};

DI void phase8(const Params& p, char* lds) {
    int* loff = (int*)(lds + pg::STAGE_BYTES); int* ltoff = loff + 40;
    build_offsets(p, loff, ltoff);
    MoeSched S; S.A = (const char*)(p.ws + WS_ACT); S.W = (const char*)(p.ws + WS_WDN); S.wstride = (size_t)D * DE * 2; S.K = DE; S.mode = 1;
    S.cnt = (const int*)(p.ws + WS_CNT); S.list = (const int*)(p.ws + WS_LIST); S.loff = loff; S.ltoff = ltoff;
    S.G = gridDim.x; S.c = blockIdx.x; S.nunits = ltoff[NE] * 4;
    EpiP8 E{p.ws, loff};
    pg::gemm_phase((LAS unsigned char*)lds, DE, S, E);
}

DI void phase9(const Params& p, char* lds) {
    float* lm = (float*)lds;
    int* loff = (int*)(lds + 4096); int* ltoff = loff + 40;
    load_modvec(lm, p, 0, 5);
    build_offsets(p, loff, ltoff);
    const int lane = threadIdx.x & 63, w = threadIdx.x >> 6;
    const float* H1 = (const float*)(p.ws + WS_Y);
    const u16* OUTP = (const u16*)(p.ws + WS_OUTP);
    const int4* tinfo = (const int4*)(p.ws + WS_TINFO);
    for (int row0 = (blockIdx.x * NWV + w) * 4; row0 < L; row0 += gridDim.x * NWV * 4) {
        float4 v[4][4];
#pragma unroll
        for (int r = 0; r < 4; ++r) {
            const int row = row0 + r;
            const int4 ti = tinfo[row];
            const u16* r1 = OUTP + (size_t)(loff[ti.x] + ti.y) * D;
            const u16* r2 = OUTP + (size_t)(loff[ti.z] + ti.w) * D;
#pragma unroll
            for (int j = 0; j < 4; ++j) {
                const int e = (j * 64 + lane) * 4;
                const f32x4 hv = __builtin_nontemporal_load((const f32x4*)(H1 + (size_t)row * D + e));
                const float4 h = make_float4(hv[0], hv[1], hv[2], hv[3]);
                const u32x2 av = __builtin_nontemporal_load((const u32x2*)(r1 + e)), bv2 = __builtin_nontemporal_load((const u32x2*)(r2 + e));
                const uint2 a = make_uint2(av[0], av[1]), b = make_uint2(bv2[0], bv2[1]);
                const float4 g2 = *(const float4*)(lm + e);
                v[r][j].x = ALPHA * h.x + g2.x * (bflo(a.x) + bflo(b.x));
                v[r][j].y = ALPHA * h.y + g2.y * (bfhi(a.x) + bfhi(b.x));
                v[r][j].z = ALPHA * h.z + g2.z * (bflo(a.y) + bflo(b.y));
                v[r][j].w = ALPHA * h.w + g2.w * (bfhi(a.y) + bfhi(b.y));
            }
        }
        ln_rows<4>(v, p.ln2_g, p.ln2_b, lane);
#pragma unroll
        for (int r = 0; r < 4; ++r)
#pragma unroll
            for (int j = 0; j < 4; ++j) { const f32x4 ov = {v[r][j].x, v[r][j].y, v[r][j].z, v[r][j].w}; __builtin_nontemporal_store(ov, (f32x4*)(p.out + (size_t)(row0 + r) * D + (j * 64 + lane) * 4)); }
    }
}

#define XB_TMO      128
#define XB_XCNT(j)  (256  + 64 * (j))
#define XB_XSUB(j)  (1280 + 64 * (j))
#define XB_XGEN(j)  (2304 + 64 * (j))
#define XB_TOP      3328
#define XB_TOPGEN   3392
#define XCD_BAR_WORDS 3456
#define XB_SPIN_CAP (1u << 18)
DI unsigned xb_ld(unsigned* p)              { return __hip_atomic_load(p, __ATOMIC_RELAXED, __HIP_MEMORY_SCOPE_AGENT); }
DI unsigned xb_add(unsigned* p, unsigned v) { return __hip_atomic_fetch_add(p, v, __ATOMIC_RELAXED, __HIP_MEMORY_SCOPE_AGENT); }
DI unsigned xb_xcc_id() { return (unsigned)__builtin_amdgcn_s_getreg((3 << 11) | 20) & 0xFu; }
#define XB_SPIN(cond, bar) do { unsigned _sp = 0; while (cond) { __builtin_amdgcn_s_sleep(1); \
    if ((++_sp & 255u) == 0u) { if (xb_ld(&(bar)[XB_TMO])) break; if (_sp > XB_SPIN_CAP) { atomicAdd(&(bar)[XB_TMO], 1u); break; } } } } while (0)
struct XcdBarrier { unsigned* bar; unsigned x; volatile LAS unsigned* st; };
DI XcdBarrier xcd_barrier_post(unsigned* bar, volatile LAS unsigned* st) {
    XcdBarrier b; b.bar = bar; b.x = xb_xcc_id(); b.st = st;
    if (threadIdx.x == 0) (void)xb_add(&bar[XB_XCNT(b.x)], 1u);
    return b;
}
DI void xcd_barrier_complete(unsigned* bar, unsigned x, unsigned& nloc, unsigned& nx) {
    const unsigned G = gridDim.x * gridDim.y * gridDim.z;
    unsigned sum, cnt, mine, sp = 0u;
    for (;;) {
        sum = 0u; cnt = 0u; mine = 0u;
#pragma unroll
        for (unsigned j = 0; j < 16; ++j) { const unsigned c = xb_ld(&bar[XB_XCNT(j)]); sum += c; cnt += (c > 0u) ? 1u : 0u; mine = (j == x) ? c : mine; }
        if (sum == G) break;
        __builtin_amdgcn_s_sleep(1);
        if ((++sp & 255u) == 0u) { if (xb_ld(&bar[XB_TMO])) break; if (sp > XB_SPIN_CAP) { atomicAdd(&bar[XB_TMO], 1u); break; } }
    }
    nloc = mine > 0u ? mine : 1u; nx = cnt > 0u ? cnt : 1u;
}
DI void xcd_barrier(const XcdBarrier& b) {
    asm volatile("s_waitcnt vmcnt(0)" ::: "memory");
    __syncthreads();
    if (threadIdx.x == 0) {
        unsigned* bar = b.bar;
        __builtin_amdgcn_s_waitcnt(0);
        unsigned nloc = b.st[0], nx = b.st[1];
        if (nloc == 0u) { xcd_barrier_complete(bar, b.x, nloc, nx); b.st[0] = nloc; b.st[1] = nx; }
        const unsigned old = xb_add(&bar[XB_XSUB(b.x)], 1u);
        const unsigned gen = old / nloc;
        if (old + 1u == (gen + 1u) * nloc) {
            __builtin_amdgcn_fence(__ATOMIC_RELEASE, "agent");
            asm volatile("s_waitcnt vmcnt(0)" ::: "memory");
            const unsigned og = xb_add(&bar[XB_TOP], 1u);
            const unsigned tg = og / nx;
            if (og + 1u == (tg + 1u) * nx) xb_add(&bar[XB_TOPGEN], 1u);
            else XB_SPIN(xb_ld(&bar[XB_TOPGEN]) == tg, bar);
            __builtin_amdgcn_fence(__ATOMIC_ACQUIRE, "agent");
            xb_add(&bar[XB_XGEN(b.x)], 1u);
            asm volatile("s_waitcnt vmcnt(0)" ::: "memory");
        } else {
            XB_SPIN(xb_ld(&bar[XB_XGEN(b.x)]) == gen, bar);
            __builtin_amdgcn_fence(__ATOMIC_ACQUIRE, "agent");
            asm volatile("s_waitcnt vmcnt(0)" ::: "memory");
        }
    }
    __syncthreads();
}

extern __shared__ __attribute__((aligned(16))) char dyn_lds[];
constexpr int LDS_TOTAL = 152576;

__global__ void __launch_bounds__(512, 2) fwd_mega(Params p) {
    cg::grid_group grid = cg::this_grid();
    char* lds = dyn_lds;
    __shared__ uint4 xb_words;
    if (threadIdx.x == 0) xb_words = make_uint4(0u, 0u, 0u, 0u);
    __syncthreads();
    XcdBarrier xb = xcd_barrier_post((unsigned*)(p.ws + WS_BAR), (volatile LAS unsigned*)&xb_words);
    if (p.ph_hi > 1000) grid.sync();
#ifndef DUP_MASK
#define DUP_MASK 0
#endif
#define RUN_PHASE(n) if (p.ph_lo <= n && n < p.ph_hi) { phase##n(p, lds); if ((DUP_MASK >> n) & 1) { xcd_barrier(xb); phase##n(p, lds); } if (n + 1 < p.ph_hi) xcd_barrier(xb); }
    if (p.ph_lo <= 0 && 0 < p.ph_hi) { phase0(p, lds); if (p.ph_hi == 1) {} }
    RUN_PHASE(1) RUN_PHASE(2) RUN_PHASE(3) RUN_PHASE(4)
    if (p.ph_lo <= 5 && 5 < p.ph_hi) phase5(p, lds);
    RUN_PHASE(6) RUN_PHASE(7) RUN_PHASE(8) RUN_PHASE(9)
#undef RUN_PHASE
}

extern "C" void kernel_launch(void* const* d_in, const int* in_sizes, int n_in, void* d_out, int out_size, void* d_ws, size_t ws_size, hipStream_t stream) {
    static int grid_blocks = 0;
    if (!grid_blocks) {
        int dev = 0, cus = 0, per_cu = 0;
        hipGetDevice(&dev);
        hipDeviceGetAttribute(&cus, hipDeviceAttributeMultiprocessorCount, dev);
        hipFuncSetAttribute((const void*)fwd_mega, hipFuncAttributeMaxDynamicSharedMemorySize, LDS_TOTAL);
        hipOccupancyMaxActiveBlocksPerMultiprocessor(&per_cu, (const void*)fwd_mega, NTH, LDS_TOTAL);
        if (per_cu < 1) per_cu = 1;
        if (per_cu > 1) per_cu = 1;
        grid_blocks = cus * per_cu;
        if (ws_size < WS_END) fprintf(stderr, "kernel_launch: workspace too small: %zu < %zu\n", ws_size, (size_t)WS_END);
    }
    Params p{};
    const float** pf = (const float**)&p;
    for (int i = 0; i < 26; ++i) pf[i] = (const float*)d_in[i];
    p.out = (float*)d_out;
    p.ws = (unsigned char*)d_ws;
#if N_LAUNCH_MODE == 1
    (void)hipMemsetAsync((char*)d_ws + WS_BAR, 0, XCD_BAR_WORDS * 4, stream);
    p.ph_lo = 0; p.ph_hi = NPHASE;
    void* args[] = {&p};
    hipError_t e = hipLaunchCooperativeKernel((const void*)fwd_mega, dim3(grid_blocks), dim3(NTH), args, LDS_TOTAL, stream);
    if (e != hipSuccess) fprintf(stderr, "cooperative launch failed: %s (grid %d)\n", hipGetErrorString(e), grid_blocks);
#else
    for (int ph = 0; ph < NPHASE; ++ph) {
        p.ph_lo = ph; p.ph_hi = ph + 1;
        hipLaunchKernelGGL(fwd_mega, dim3(grid_blocks), dim3(NTH), LDS_TOTAL, stream, p);
#ifdef PROBE_DUP
        if (ph == PROBE_DUP) hipLaunchKernelGGL(fwd_mega, dim3(grid_blocks), dim3(NTH), LDS_TOTAL, stream, p);
#endif
    }
#endif
}
```

```cpp
#include <hip/hip_runtime.h>
#include <hip/hip_cooperative_groups.h>
#include <cstdio>
namespace cg = cooperative_groups;

#ifndef N_LAUNCH_MODE
#define N_LAUNCH_MODE 1
#endif

typedef unsigned short u16;
typedef __attribute__((ext_vector_type(8))) short bf16x8;
typedef __attribute__((ext_vector_type(16))) float f32x16;
#define DI __device__ __forceinline__
#define MFMA(a, b, c) __builtin_amdgcn_mfma_f32_32x32x16_bf16((a), (b), (c), 0, 0, 0)

constexpr int D = 1024, L = 16384, CTX = 256, MT = L + CTX;
constexpr int ATT = 512, PROJ = 4096;
constexpr int NE = 32, DE = 512, CAP = 16384;
constexpr float ALPHA = 1.189207115002721f;
constexpr float LN_EPS = 1e-5f;
constexpr int NPHASE = 10;
constexpr int NTH = 512, NWV = 8;

constexpr size_t al(size_t x) { return (x + 255) & ~(size_t)255; }
constexpr size_t WS_WIN   = 0;
constexpr size_t WS_WA    = WS_WIN  + al((size_t)PROJ * D * 2);
constexpr size_t WS_WPC   = WS_WA   + al((size_t)D * ATT * 2);
constexpr size_t WS_WOUT  = WS_WPC  + al((size_t)D * ATT * 2);
constexpr size_t WS_WGU   = WS_WOUT + al((size_t)D * D * 2);
constexpr size_t WS_WDN   = WS_WGU  + al((size_t)NE * 1024 * D * 2);
constexpr size_t WS_WRT   = WS_WDN  + al((size_t)NE * D * DE * 2);
constexpr size_t WS_MODP  = WS_WRT  + al((size_t)36 * D * 4);
constexpr size_t WS_CNT   = WS_MODP + al((size_t)16 * 2 * 6144 * 4);
constexpr size_t WS_LIST  = WS_CNT  + 64 * 256;
constexpr size_t WS_CW    = WS_LIST + al((size_t)NE * CAP * 4);
constexpr size_t WS_TINFO = WS_CW   + al((size_t)NE * CAP * 4);
constexpr size_t WS_BAR   = WS_TINFO + al((size_t)L * 16);
constexpr size_t WS_HM    = WS_BAR  + al((size_t)3456 * 4);
constexpr size_t WS_VT    = WS_HM   + (size_t)MT * D * 2;
constexpr size_t WS_POOL  = WS_VT   + (size_t)ATT * MT * 2;
constexpr size_t WS_Q     = WS_POOL + (size_t)L * ATT * 2;
constexpr size_t WS_K     = WS_Q    + (size_t)MT * ATT * 2;
constexpr size_t WS_SA    = WS_K    + (size_t)MT * ATT * 2;
constexpr size_t WS_SB    = WS_SA   + (size_t)L * D * 2;
constexpr size_t WS_END   = WS_SB   + (size_t)L * D * 2;
constexpr size_t WS_YATT  = WS_HM;
constexpr size_t WS_POOLED= WS_HM + (size_t)L * ATT * 2;
constexpr size_t WS_Z     = WS_Q;
constexpr size_t WS_Y     = WS_SA;
constexpr size_t WS_HM2   = WS_HM;
constexpr size_t WS_ACT   = WS_Q;
constexpr size_t WS_OUTP  = WS_HM;
static_assert(WS_HM + (size_t)2 * L * D * 2 <= WS_Q, "outp must fit in HM+VT+POOL");
static_assert((size_t)2 * L * DE * 2 <= (size_t)2 * MT * ATT * 2, "act must fit in Q+K");

struct Params {
    const float *x, *c, *ctx, *c_ctx, *ln_in_g, *ln_in_b, *w_mod, *b_mod, *w_in, *rpb, *w_pool_grp, *pool_scale,
                *w_attn_proj, *w_pool_proj, *w_out, *ln1_g, *ln1_b, *w_rg, *b_rg, *w_re, *b_re, *w_gate, *w_up, *w_down, *ln2_g, *ln2_b;
    float* out;
    unsigned char* ws;
    int ph_lo, ph_hi;
};

DI u16 f2bf(float x) { __bf16 b = (__bf16)x; return __builtin_bit_cast(u16, b); }
DI float bf2f(u16 b) { return __uint_as_float(((unsigned)b) << 16); }
typedef __bf16 bf16x2_t __attribute__((ext_vector_type(2)));
typedef float f32x2_t __attribute__((ext_vector_type(2)));
DI unsigned pack2(float a, float b) { f32x2_t v = {a, b}; bf16x2_t r = __builtin_convertvector(v, bf16x2_t); return __builtin_bit_cast(unsigned, r); }
template <int CTRL> DI float dpp_f(float v) { return __int_as_float(__builtin_amdgcn_update_dpp(0, __float_as_int(v), CTRL, 0xF, 0xF, true)); }
DI float rl(float v, int l) { return __int_as_float(__builtin_amdgcn_readlane(__float_as_int(v), l)); }
DI float row_sum16(float v) {
    v += dpp_f<0xB1>(v); v += dpp_f<0x4E>(v); v += dpp_f<0x141>(v); v += dpp_f<0x140>(v); return v;
}
DI float wave_sum(float v) { v = row_sum16(v); return (rl(v, 0) + rl(v, 16)) + (rl(v, 32) + rl(v, 48)); }
DI float sigmoidf_(float x) { return __builtin_amdgcn_rcpf(1.f + __expf(-x)); }
DI float siluf_(float x) { return x * __builtin_amdgcn_rcpf(1.f + __expf(-x)); }

#define LAS __attribute__((address_space(3)))
typedef float f32x4 __attribute__((ext_vector_type(4)));
typedef unsigned u32x4 __attribute__((ext_vector_type(4)));
typedef unsigned u32x2 __attribute__((ext_vector_type(2)));
namespace pg {
constexpr int BM = 256, BK = 64, HALF = 128, HTB = HALF * BK * 2, STAGE_BYTES = 8 * HTB, NXCD = 8, WGM = 8;
DI int lds_byte(int r, int c) { const int st = (r >> 4) * 2 + (c >> 5), rr = r & 15, cc = c & 31, ob = rr * 64 + cc * 2; return st * 1024 + (ob ^ (((ob >> 9) & 1) << 5)); }
DI void stage_rc(int b, int& R, int& C) { const int st = b / 1024, sb = b % 1024, swz = sb ^ (((sb >> 9) & 1) << 5); R = (st >> 1) * 16 + swz / 64; C = (st & 1) * 32 + (swz % 64) / 2; }
DI int perm32(int rho) { const int n = rho >> 4, i = rho & 15; return 8 * (i >> 2) + 4 * n + (i & 3); }
DI unsigned cvt_pk_bf16(float lo, float hi) { return pack2(lo, hi); }

struct Unit { int pm, pn, e, tl, cnt; const char* A; const char* B; unsigned ao[2][2]; };

struct DenseSched {
    const char* A; const char* Bt; int nM, nN, nwg, G, c, K;
    DI void init(const void* A_, const void* Bt_, int M, int N, int K_) { A = (const char*)A_; Bt = (const char*)Bt_; nM = M / BM; nN = N / BM; nwg = nM * nN; G = gridDim.x; c = blockIdx.x; K = K_; }
    DI bool next(int i, Unit& u, const int (&R)[2], const int (&C)[2]) const {
        const long Lx = (long)i * G + c; if (Lx >= nwg) return false;
        int wgid = (int)Lx; { const int q = nwg / NXCD, r = nwg % NXCD, xcd = wgid % NXCD, off = wgid / NXCD; wgid = (xcd < r ? xcd * (q + 1) : r * (q + 1) + (xcd - r) * q) + off; }
        const int nig = WGM * nN, gid = wgid / nig, fm = gid * WGM, gsz = (nM - fm) < WGM ? (nM - fm) : WGM;
        u.pm = fm + ((wgid % nig) % gsz); u.pn = (wgid % nig) / gsz; u.e = 0; u.tl = u.pm; u.cnt = 0x7fffffff;
        u.A = A; u.B = Bt + (size_t)u.pn * BM * K * 2;
#pragma unroll
        for (int h = 0; h < 2; ++h)
#pragma unroll
            for (int j = 0; j < 2; ++j) u.ao[h][j] = (unsigned)((u.pm * BM + h * HALF + R[j]) * K + C[j]) * 2u;
        return true;
    }
};

template <class Epi, class Sched>
DI void gemm_phase(LAS unsigned char* lds, const int K, const Sched& S, const Epi& E) {
    const int tid = threadIdx.x, wid = __builtin_amdgcn_readfirstlane(tid >> 6), lane = tid & 63, wr = wid >> 2, wc = wid & 3, fr = lane & 15, fq = lane >> 4;
    const int nt = K / BK;
    int sR[2], sC[2]; unsigned voffB[2];
#pragma unroll
    for (int i = 0; i < 2; ++i) { stage_rc(tid * 16 + i * 8192, sR[i], sC[i]); const int Rb = Epi::PERM ? ((sR[i] & ~31) + perm32(sR[i] & 31)) : sR[i];
        voffB[i] = (unsigned)(Rb * K + sC[i]) * 2u; }
    const size_t kstep = (size_t)(BK * 2);
    const size_t hstep = (size_t)HALF * K * 2;
    const unsigned ldsw = (unsigned)wid * 1024u;
    const int aoff = lds_byte(wr * 64 + fr, fq * 8), boff = lds_byte(wc * 32 + fr, fq * 8);
#define PG_SA(b, h) (((b) * 2 + (h)) * HTB)
#define PG_SB(b, h) ((4 + (b) * 2 + (h)) * HTB)
#define PG_STAGE(bufoff, gbase, voff) do { _Pragma("unroll") for (int _i = 0; _i < 2; ++_i) \
        __builtin_amdgcn_global_load_lds((const unsigned*)((const char*)(gbase) + (voff)[_i]), (LAS unsigned*)(lds + (bufoff) + ldsw + _i * 8192), 16, 0, 0); } while (0)
#define PG_LDA(dst, b, h) do { _Pragma("unroll") for (int m = 0; m < 4; ++m) _Pragma("unroll") for (int k = 0; k < 2; ++k) dst[m][k] = *(const LAS bf16x8*)(lds + PG_SA(b, h) + aoff + m * 2048 + k * 1024); } while (0)
#define PG_LDB(dst, b, h) do { _Pragma("unroll") for (int n = 0; n < 2; ++n) _Pragma("unroll") for (int k = 0; k < 2; ++k) dst[n][k] = *(const LAS bf16x8*)(lds + PG_SB(b, h) + boff + n * 2048 + k * 1024); } while (0)
#define PG_MMA(ai, bj, At, Bt) do { __builtin_amdgcn_s_setprio(1); _Pragma("unroll") for (int m = 0; m < 4; ++m) _Pragma("unroll") for (int n = 0; n < 2; ++n) _Pragma("unroll") for (int k = 0; k < 2; ++k) \
        acc[ai][bj][m][n] = __builtin_amdgcn_mfma_f32_16x16x32_bf16(Bt[n][k], At[m][k], acc[ai][bj][m][n], 0, 0, 0); __builtin_amdgcn_s_setprio(0); } while (0)
#define PG_WAIT_V(n) asm volatile("s_waitcnt vmcnt(" #n ")" ::: "memory")
#define PG_WAIT_L(n) asm volatile("s_waitcnt lgkmcnt(" #n ")" ::: "memory")
#define PG_BAR __builtin_amdgcn_s_barrier()
#define PG_SCHED __builtin_amdgcn_sched_barrier(0)
    Unit cur, nxt; int ui = 0;
    if (!S.next(0, cur, sR, sC)) return;
    f32x4 acc[2][2][4][2];
#pragma unroll
    for (int a = 0; a < 2; ++a)
#pragma unroll
        for (int b = 0; b < 2; ++b)
#pragma unroll
            for (int m = 0; m < 4; ++m)
#pragma unroll
                for (int n = 0; n < 2; ++n) acc[a][b][m][n] = (f32x4){0.f, 0.f, 0.f, 0.f};
    bf16x8 At[4][2], B0[2][2], B1[2][2];
    PG_STAGE(PG_SB(0, 0), cur.B, voffB); PG_STAGE(PG_SB(0, 1), cur.B + hstep, voffB); PG_STAGE(PG_SA(0, 0), cur.A, cur.ao[0]); PG_STAGE(PG_SA(0, 1), cur.A, cur.ao[1]);
    if (wr == 1) PG_BAR;
    PG_WAIT_V(2); PG_BAR;
    PG_STAGE(PG_SB(1, 0), cur.B + kstep, voffB); PG_STAGE(PG_SA(1, 0), cur.A + kstep, cur.ao[0]); PG_STAGE(PG_SB(1, 1), cur.B + hstep + kstep, voffB);
    PG_WAIT_V(6); PG_BAR;
    for (;;) {
        const bool has_next = S.next(ui + 1, nxt, sR, sC);
        if (!has_next) nxt = cur;
        for (int t = 0; t < nt; t += 2) {
            const bool last = (t == nt - 2);
            const char* a1 = cur.A + (size_t)(t + 1) * kstep;
            const char* a2 = last ? nxt.A : cur.A + (size_t)(t + 2) * kstep; const char* b2 = last ? nxt.B : cur.B + (size_t)(t + 2) * kstep;
            const char* a3 = a2 + kstep; const char* b3 = b2 + kstep;
            unsigned s0[2], s1[2];
            s0[0] = last ? nxt.ao[0][0] : cur.ao[0][0]; s0[1] = last ? nxt.ao[0][1] : cur.ao[0][1];
            s1[0] = last ? nxt.ao[1][0] : cur.ao[1][0]; s1[1] = last ? nxt.ao[1][1] : cur.ao[1][1];
            PG_LDB(B0, 0, 0); PG_LDB(B1, 0, 1); PG_SCHED; PG_LDA(At, 0, 0); PG_STAGE(PG_SA(1, 1), a1, cur.ao[1]);
            PG_WAIT_V(8); PG_WAIT_L(0); PG_BAR; PG_MMA(0, 0, At, B0); PG_MMA(0, 1, At, B1); PG_BAR; PG_SCHED;
            PG_LDA(At, 0, 1); PG_STAGE(PG_SB(0, 0), b2, voffB); PG_STAGE(PG_SB(0, 1), b2 + hstep, voffB); PG_STAGE(PG_SA(0, 0), a2, s0);
            PG_WAIT_V(8); PG_WAIT_L(0); PG_BAR; PG_MMA(1, 0, At, B0); PG_MMA(1, 1, At, B1); PG_BAR; PG_SCHED;
            PG_LDB(B0, 1, 0); PG_LDB(B1, 1, 1); PG_SCHED; PG_LDA(At, 1, 0); PG_STAGE(PG_SA(0, 1), a2, s1);
            PG_WAIT_V(8); PG_WAIT_L(0); PG_BAR; PG_MMA(0, 0, At, B0); PG_MMA(0, 1, At, B1); PG_BAR; PG_SCHED;
            PG_LDA(At, 1, 1); PG_STAGE(PG_SB(1, 0), b3, voffB); PG_STAGE(PG_SB(1, 1), b3 + hstep, voffB); PG_STAGE(PG_SA(1, 0), a3, s0);
            PG_WAIT_V(8); PG_WAIT_L(0); PG_BAR; PG_MMA(1, 0, At, B0); PG_MMA(1, 1, At, B1); PG_BAR; PG_SCHED;
        }
        if (wr == 0) PG_BAR;
        E(acc, cur, wr, wc, fr, fq);
        if (!has_next) break;
#pragma unroll
        for (int a = 0; a < 2; ++a)
#pragma unroll
            for (int b = 0; b < 2; ++b)
#pragma unroll
                for (int m = 0; m < 4; ++m)
#pragma unroll
                    for (int n = 0; n < 2; ++n) acc[a][b][m][n] = (f32x4){0.f, 0.f, 0.f, 0.f};
        cur = nxt; ++ui;
        if (wr == 1) PG_BAR;
    }
    PG_WAIT_V(0);
    PG_BAR;
#undef PG_SA
#undef PG_SB
#undef PG_STAGE
#undef PG_LDA
#undef PG_LDB
#undef PG_MMA
#undef PG_WAIT_V
#undef PG_WAIT_L
#undef PG_BAR
#undef PG_SCHED
}
}

DI u32x4 pack8v(const f32x4& v0, const f32x4& v1) {
    u32x4 w; w.x = pg::cvt_pk_bf16(v0[0], v0[1]); w.y = pg::cvt_pk_bf16(v0[2], v0[3]); w.z = pg::cvt_pk_bf16(v1[0], v1[1]); w.w = pg::cvt_pk_bf16(v1[2], v1[3]); return w;
}
DI float bflo(unsigned u) { return __uint_as_float(u << 16); }
DI float bfhi(unsigned u) { return __uint_as_float(u & 0xffff0000u); }

struct TpDesc { const float* src; u16* dst; int ld_src, ld_dst, r0, c0, mode; };
constexpr int TP_WIN = 512, TP_WA = 64, TP_WOUT = 128, TP_G = 2048, TP_U = 2048, TP_DN = 2048;
constexpr int TP_TOTAL = TP_WIN + TP_WA + TP_WOUT + TP_G + TP_U + TP_DN;
DI TpDesc tp_decode(const Params& p, int i) {
    TpDesc d;
    if (i < TP_WIN) { d.src = p.w_in; d.ld_src = PROJ; d.dst = (u16*)(p.ws + WS_WIN); d.ld_dst = D; d.r0 = (i / 32) * 64; d.c0 = (i % 32) * 128; d.mode = 0; return d; }
    i -= TP_WIN;
    if (i < TP_WA) { d.src = p.w_attn_proj; d.ld_src = D; d.dst = (u16*)(p.ws + WS_WA); d.ld_dst = ATT; d.r0 = (i / 8) * 64; d.c0 = (i % 8) * 128; d.mode = 0; return d; }
    i -= TP_WA;
    if (i < TP_WOUT) { d.src = p.w_out; d.ld_src = D; d.dst = (u16*)(p.ws + WS_WOUT); d.ld_dst = D; d.r0 = (i / 8) * 64; d.c0 = (i % 8) * 128; d.mode = 0; return d; }
    i -= TP_WOUT;
    if (i < TP_G) { const int e = i >> 6, j = i & 63;
        d.src = p.w_gate + (size_t)e * D * DE; d.ld_src = DE; d.dst = (u16*)(p.ws + WS_WGU) + (size_t)e * 1024 * D; d.ld_dst = D; d.r0 = (j / 4) * 64; d.c0 = (j % 4) * 128; d.mode = 1; return d; }
    i -= TP_G;
    if (i < TP_U) { const int e = i >> 6, j = i & 63;
        d.src = p.w_up + (size_t)e * D * DE; d.ld_src = DE; d.dst = (u16*)(p.ws + WS_WGU) + (size_t)e * 1024 * D; d.ld_dst = D; d.r0 = (j / 4) * 64; d.c0 = (j % 4) * 128; d.mode = 2; return d; }
    i -= TP_U;
    { const int e = i >> 6, j = i & 63;
        d.src = p.w_down + (size_t)e * DE * D; d.ld_src = D; d.dst = (u16*)(p.ws + WS_WDN) + (size_t)e * D * DE; d.ld_dst = DE; d.r0 = (j / 8) * 64; d.c0 = (j % 8) * 128; d.mode = 0; return d; }
}
DI void tp_load(const TpDesc& d, f32x4 (&v)[4]) {
    const int sub = threadIdx.x >> 8, t = threadIdx.x & 255;
#pragma unroll
    for (int i = 0; i < 4; ++i) {
        const int row = (t >> 4) + 16 * i, c4 = (t & 15) * 4;
        v[i] = __builtin_nontemporal_load((const f32x4*)(d.src + (size_t)(d.r0 + row) * d.ld_src + d.c0 + sub * 64 + c4));
    }
}
DI void tp_to_lds(float* lt, const f32x4 (&v)[4]) {
    const int sub = threadIdx.x >> 8, t = threadIdx.x & 255;
    lt += sub * 64 * 65;
#pragma unroll
    for (int i = 0; i < 4; ++i) {
        const int row = (t >> 4) + 16 * i, c4 = (t & 15) * 4;
        lt[row * 65 + c4 + 0] = v[i][0]; lt[row * 65 + c4 + 1] = v[i][1]; lt[row * 65 + c4 + 2] = v[i][2]; lt[row * 65 + c4 + 3] = v[i][3];
    }
}
DI void tp_store(const float* lt, const TpDesc& d) {
    const int sub = threadIdx.x >> 8, t = threadIdx.x & 255;
    lt += sub * 64 * 65;
    const int c = t >> 2, rc = (t & 3) * 16;
    const int cg_ = d.c0 + sub * 64 + c;
    int drow = cg_;
    if (d.mode == 1) drow = (cg_ >> 7) * 256 + (cg_ & 127);
    else if (d.mode == 2) drow = (cg_ >> 7) * 256 + (cg_ & 127) + 128;
    unsigned pk[8];
#pragma unroll
    for (int e = 0; e < 8; ++e) pk[e] = pack2(lt[(rc + 2 * e) * 65 + c], lt[(rc + 2 * e + 1) * 65 + c]);
    uint4* dp = (uint4*)(d.dst + (size_t)drow * d.ld_dst + d.r0 + rc);
    dp[0] = make_uint4(pk[0], pk[1], pk[2], pk[3]);
    dp[1] = make_uint4(pk[4], pk[5], pk[6], pk[7]);
}

DI void phase0(const Params& p, char* lds) {
    float* lt = (float*)lds;
    const int t = threadIdx.x;
    constexpr int I_MOD = 192, I_WPC = 64, I_MISC = 1;
    for (int it = blockIdx.x; it < I_MOD + I_WPC + I_MISC; it += gridDim.x) {
        int i = it;
        if (i < I_MOD) {
            const int cc = i % 12, kc = i / 12;
            const int col = cc * 512 + t;
            float* lsil = (float*)lds;
            __syncthreads();
            if (t < 128) { const int k = kc * 64 + (t & 63); lsil[t] = siluf_((t < 64) ? p.c[k] : p.c_ctx[k]); }
            __syncthreads();
            float a0 = 0.f, a1 = 0.f;
#pragma unroll
            for (int kb = 0; kb < 4; ++kb) {
                float wv[16];
#pragma unroll
                for (int j = 0; j < 16; ++j) wv[j] = __builtin_nontemporal_load(p.w_mod + (size_t)(kc * 64 + kb * 16 + j) * 6144 + col);
#pragma unroll
                for (int j = 0; j < 16; ++j) { a0 += lsil[kb * 16 + j] * wv[j]; a1 += lsil[64 + kb * 16 + j] * wv[j]; }
            }
            if (kc == 0) { const float b = p.b_mod[col]; a0 += b; a1 += b; }
            float* modp = (float*)(p.ws + WS_MODP);
            modp[(kc * 2 + 0) * 6144 + col] = a0;
            modp[(kc * 2 + 1) * 6144 + col] = a1;
            asm volatile("s_waitcnt vmcnt(0)" ::: "memory");
            __syncthreads();
            if (t == 0) {
                __builtin_amdgcn_fence(__ATOMIC_RELEASE, "agent");
                asm volatile("s_waitcnt vmcnt(0)" ::: "memory");
                (void)__hip_atomic_fetch_add((unsigned*)(p.ws + WS_BAR) + 96, 1u, __ATOMIC_RELAXED, __HIP_MEMORY_SCOPE_AGENT);
            }
            continue;
        }
        i -= I_MOD;
        if (i < I_WPC) {
            const int o0 = (i / 4) * 64, g = i % 4;
            float* lw = (float*)lds;
            __syncthreads();
            for (int e = t; e < 128 * 128; e += NTH) lw[e] = p.w_pool_grp[(size_t)g * 16384 + e] * p.pool_scale[g * 128 + (e & 127)];
            __syncthreads();
            const int o = o0 + (t & 63);
            const int iw = (t >> 6) * 16;
            float a[16];
#pragma unroll
            for (int e = 0; e < 16; ++e) a[e] = 0.f;
            for (int jb = 0; jb < 128; jb += 8) {
                float wp[8];
#pragma unroll
                for (int q = 0; q < 8; ++q) wp[q] = p.w_pool_proj[(size_t)(g * 128 + jb + q) * D + o];
#pragma unroll
                for (int e = 0; e < 16; ++e) {
                    const float4 l0 = *(const float4*)(lw + (iw + e) * 128 + jb), l1 = *(const float4*)(lw + (iw + e) * 128 + jb + 4);
                    a[e] += l0.x * wp[0] + l0.y * wp[1] + l0.z * wp[2] + l0.w * wp[3] + l1.x * wp[4] + l1.y * wp[5] + l1.z * wp[6] + l1.w * wp[7];
                }
            }
            unsigned pk[8];
#pragma unroll
            for (int e = 0; e < 8; ++e) pk[e] = pack2(a[2 * e], a[2 * e + 1]);
            uint4* dp = (uint4*)((u16*)(p.ws + WS_WPC) + (size_t)o * ATT + g * 128 + iw);
            dp[0] = make_uint4(pk[0], pk[1], pk[2], pk[3]);
            dp[1] = make_uint4(pk[4], pk[5], pk[6], pk[7]);
            continue;
        }
        {
            float* wrt = (float*)(p.ws + WS_WRT);
#pragma unroll
            for (int kk = 0; kk < 2; ++kk) {
                const int k = t + kk * NTH;
                const float4 rg = *(const float4*)(p.w_rg + (size_t)k * 4);
                float4 re[8];
#pragma unroll
                for (int q = 0; q < 8; ++q) re[q] = *(const float4*)(p.w_re + (size_t)k * 32 + q * 4);
                wrt[0 * 1024 + k] = rg.x; wrt[1 * 1024 + k] = rg.y; wrt[2 * 1024 + k] = rg.z; wrt[3 * 1024 + k] = rg.w;
#pragma unroll
                for (int q = 0; q < 8; ++q) {
                    wrt[(4 + q * 4 + 0) * 1024 + k] = re[q].x; wrt[(4 + q * 4 + 1) * 1024 + k] = re[q].y;
                    wrt[(4 + q * 4 + 2) * 1024 + k] = re[q].z; wrt[(4 + q * 4 + 3) * 1024 + k] = re[q].w;
                }
            }
            if (t < 33) ((int*)(p.ws + WS_CNT))[t * 64] = 0;
        }
    }
    __syncthreads();
    {
        constexpr int TP_P0 = TP_TOTAL - TP_DN;
        unsigned* qhead = (unsigned*)(p.ws + WS_BAR) + 64;
        int* lq = (int*)(lds + 4 * 64 * 65 * 4);
        float* lt0 = lt; float* lt1 = lt + 2 * 64 * 65;
        __syncthreads();
        if (t == 0) lq[0] = (int)atomicAdd(qhead, 2u);
        __syncthreads();
        int ia = lq[0];
        if (ia < TP_P0) {
            TpDesc da = tp_decode(p, ia), db = tp_decode(p, ia + 1);
            f32x4 ra[4], rb[4];
            tp_load(da, ra); tp_load(db, rb);
            for (;;) {
                __syncthreads();
                if (t == 0) lq[0] = (int)atomicAdd(qhead, 2u);
                tp_to_lds(lt0, ra); tp_to_lds(lt1, rb);
                __syncthreads();
                const TpDesc ca = da, cb = db;
                const int na = lq[0];
                const bool more = na < TP_P0;
                da = tp_decode(p, more ? na : ia); db = tp_decode(p, more ? na + 1 : ia);
                tp_load(da, ra); tp_load(db, rb);
                tp_store(lt0, ca); tp_store(lt1, cb);
                if (!more) break;
                ia = na;
            }
        }
        __syncthreads();
    }
}

DI void load_modvec(float* dst, const Params& p, int cond, int vec) {
    const float* modp = (const float*)(p.ws + WS_MODP);
    for (int i = threadIdx.x; i < 1024; i += NTH) {
        float s = 0.f;
#pragma unroll
        for (int kc = 0; kc < 16; ++kc) s += modp[(kc * 2 + cond) * 6144 + vec * 1024 + i];
        dst[i] = s;
    }
}

template <int NB>
DI void ln_rows(float4 (&v)[NB][4], const float* g, const float* b, int lane) {
    float mu[NB], rstd[NB];
#pragma unroll
    for (int r = 0; r < NB; ++r) {
        float s = 0.f;
#pragma unroll
        for (int j = 0; j < 4; ++j) s += v[r][j].x + v[r][j].y + v[r][j].z + v[r][j].w;
        mu[r] = s;
    }
#pragma unroll
    for (int r = 0; r < NB; ++r) mu[r] = wave_sum(mu[r]) * (1.f / 1024.f);
#pragma unroll
    for (int r = 0; r < NB; ++r) {
        float q = 0.f;
#pragma unroll
        for (int j = 0; j < 4; ++j) {
            v[r][j].x -= mu[r]; v[r][j].y -= mu[r]; v[r][j].z -= mu[r]; v[r][j].w -= mu[r];
            q += v[r][j].x * v[r][j].x + v[r][j].y * v[r][j].y + v[r][j].z * v[r][j].z + v[r][j].w * v[r][j].w;
        }
        rstd[r] = q;
    }
#pragma unroll
    for (int r = 0; r < NB; ++r) rstd[r] = rsqrtf(wave_sum(rstd[r]) * (1.f / 1024.f) + LN_EPS);
#pragma unroll
    for (int j = 0; j < 4; ++j) {
        const float4 gg = *(const float4*)(g + (j * 64 + lane) * 4);
        const float4 bb = *(const float4*)(b + (j * 64 + lane) * 4);
#pragma unroll
        for (int r = 0; r < NB; ++r) {
            v[r][j].x = v[r][j].x * rstd[r] * gg.x + bb.x; v[r][j].y = v[r][j].y * rstd[r] * gg.y + bb.y;
            v[r][j].z = v[r][j].z * rstd[r] * gg.z + bb.z; v[r][j].w = v[r][j].w * rstd[r] * gg.w + bb.w;
        }
    }
}

DI void phase1(const Params& p, char* lds) {
    if (threadIdx.x == 0) {
        unsigned* mc = (unsigned*)(p.ws + WS_BAR) + 96;
        unsigned sp = 0;
        while (__hip_atomic_load(mc, __ATOMIC_RELAXED, __HIP_MEMORY_SCOPE_AGENT) < 192u) { __builtin_amdgcn_s_sleep(1); if (++sp > (1u << 22)) break; }
        __builtin_amdgcn_fence(__ATOMIC_ACQUIRE, "agent");
        asm volatile("s_waitcnt vmcnt(0)" ::: "memory");
    }
    __syncthreads();
    float* lm = (float*)lds;
    load_modvec(lm + 0, p, 0, 0); load_modvec(lm + 1024, p, 0, 1);
    load_modvec(lm + 2048, p, 1, 0); load_modvec(lm + 3072, p, 1, 1);
    __syncthreads();
    const int lane = threadIdx.x & 63, w = threadIdx.x >> 6;
    u16* hm = (u16*)(p.ws + WS_HM);
    for (int row0 = (blockIdx.x * NWV + w) * 4; row0 < MT; row0 += gridDim.x * NWV * 4) {
        const float* src = (row0 < L) ? (p.x + (size_t)row0 * D) : (p.ctx + (size_t)(row0 - L) * D);
        const float* sh = lm + ((row0 < L) ? 0 : 2048);
        const float* sc = sh + 1024;
        float4 v[4][4];
#pragma unroll
        for (int r = 0; r < 4; ++r)
#pragma unroll
            for (int j = 0; j < 4; ++j) { const f32x4 xv = __builtin_nontemporal_load((const f32x4*)(src + (size_t)r * D + (j * 64 + lane) * 4)); v[r][j] = make_float4(xv[0], xv[1], xv[2], xv[3]); }
        ln_rows<4>(v, p.ln_in_g, p.ln_in_b, lane);
#pragma unroll
        for (int j = 0; j < 4; ++j) {
            const int e = (j * 64 + lane) * 4;
            const float4 s4 = *(const float4*)(sh + e), c4 = *(const float4*)(sc + e);
#pragma unroll
            for (int r = 0; r < 4; ++r) {
                const float m0 = v[r][j].x * (1.f + c4.x) + s4.x, m1 = v[r][j].y * (1.f + c4.y) + s4.y;
                const float m2 = v[r][j].z * (1.f + c4.z) + s4.z, m3 = v[r][j].w * (1.f + c4.w) + s4.w;
                *(uint2*)(hm + (size_t)(row0 + r) * D + e) = make_uint2(pack2(m0, m1), pack2(m2, m3));
            }
        }
    }
}

struct EpiP2 {
    static constexpr bool PERM = true;
    unsigned char* ws; char* xl;
    DI void operator()(const f32x4 (&acc)[2][2][4][2], const pg::Unit& u, int wr, int wc, int fr, int fq) const {
        const int row0 = u.pm * 256 + wr * 64 + fr;
        const int cu = u.pn * 256;
        const int cl = wc * 32 + 8 * fq;
        if (cu >= 1024 && cu < 1536) {
            u16* VT = (u16*)(ws + WS_VT);
            const int wv = wr * 4 + wc, lane = fq * 16 + fr;
            u16* img = (u16*)(xl + wv * 2048);
#pragma unroll
            for (int ai = 0; ai < 2; ++ai)
#pragma unroll
                for (int bj = 0; bj < 2; ++bj)
#pragma unroll
                    for (int mp = 0; mp < 2; ++mp) {
#pragma unroll
                        for (int mm = 0; mm < 2; ++mm) {
                            const f32x4 v0 = acc[ai][bj][mp * 2 + mm][0], v1 = acc[ai][bj][mp * 2 + mm][1];
#pragma unroll
                            for (int j = 0; j < 4; ++j) {
                                img[(8 * fq + j) * 32 + mm * 16 + fr] = f2bf(v0[j]);
                                img[(8 * fq + 4 + j) * 32 + mm * 16 + fr] = f2bf(v1[j]);
                            }
                        }
                        asm volatile("" ::: "memory"); __builtin_amdgcn_wave_barrier();
#pragma unroll
                        for (int q = 0; q < 2; ++q) {
                            const int id = lane + 64 * q, c32 = id >> 2, part = id & 3;
                            const u32x4 w = *(const u32x4*)(img + c32 * 32 + part * 8);
                            *(u32x4*)(VT + (size_t)(cu - 1024 + bj * 128 + wc * 32 + c32) * MT + u.pm * 256 + ai * 128 + wr * 64 + mp * 32 + part * 8) = w;
                        }
                        asm volatile("" ::: "memory"); __builtin_amdgcn_wave_barrier();
                    }
            return;
        }
        u16* base; int ld; float sc = 1.f;
        if (cu < 512) { base = (u16*)(ws + WS_Q) + cu; ld = ATT; sc = 0.125f * 1.44269504089f; }
        else if (cu < 1024) { base = (u16*)(ws + WS_K) + (cu - 512); ld = ATT; }
        else if (cu < 2048) { base = (u16*)(ws + WS_POOL) + (cu - 1536); ld = ATT; }
        else if (cu < 3072) { base = (u16*)(ws + WS_SA) + (cu - 2048); ld = D; }
        else { base = (u16*)(ws + WS_SB) + (cu - 3072); ld = D; }
        base += (size_t)row0 * ld + cl;
        if (cu < 2048) {
#pragma unroll
            for (int ai = 0; ai < 2; ++ai)
#pragma unroll
                for (int m = 0; m < 4; ++m)
#pragma unroll
                    for (int bj = 0; bj < 2; ++bj)
                        *(u32x4*)(base + (size_t)(ai * 128 + m * 16) * ld + bj * 128) = pack8v(acc[ai][bj][m][0] * sc, acc[ai][bj][m][1] * sc);
        } else {
#pragma unroll
            for (int ai = 0; ai < 2; ++ai)
#pragma unroll
                for (int m = 0; m < 4; ++m)
#pragma unroll
                    for (int bj = 0; bj < 2; ++bj) {
                        f32x4 v0 = acc[ai][bj][m][0], v1 = acc[ai][bj][m][1];
#pragma unroll
                        for (int j = 0; j < 4; ++j) { v0[j] = sigmoidf_(v0[j]); v1[j] = sigmoidf_(v1[j]); }
                        __builtin_nontemporal_store(pack8v(v0, v1), (u32x4*)(base + (size_t)(ai * 128 + m * 16) * D + bj * 128));
                    }
        }
    }
};

DI void ctx_kv_item(const Params& p, int item, char* lds) {
    const int t = threadIdx.x, lane = t & 63, w = t >> 6, lr = lane & 31, lh = lane >> 5;
    const int rb = item >> 5, cb = item & 31;
    const u16* hm = (const u16*)(p.ws + WS_HM); const u16* wt = (const u16*)(p.ws + WS_WIN);
    const u16* ap = hm + (size_t)(L + rb * 32 + lr) * D + w * 128 + 8 * lh;
    const u16* bp = wt + (size_t)(512 + cb * 32 + lr) * D + w * 128 + 8 * lh;
    f32x16 acc;
#pragma unroll
    for (int i = 0; i < 16; ++i) acc[i] = 0.f;
#pragma unroll
    for (int ks = 0; ks < 8; ++ks) {
        const bf16x8 a = *(const bf16x8*)(ap + ks * 16), b = *(const bf16x8*)(bp + ks * 16);
        acc = MFMA(a, b, acc);
    }
    float* part = (float*)lds;
    __syncthreads();
#pragma unroll
    for (int i = 0; i < 16; ++i) part[(w * 32 + (i & 3) + 8 * (i >> 2) + 4 * lh) * 33 + lr] = acc[i];
    __syncthreads();
    const int row = t >> 4, c = (t & 15) * 2;
    float s0 = 0.f, s1 = 0.f;
#pragma unroll
    for (int ww = 0; ww < 8; ++ww) { s0 += part[(ww * 32 + row) * 33 + c]; s1 += part[(ww * 32 + row) * 33 + c + 1]; }
    const int grow = L + rb * 32 + row;
    if (cb < 16) {
        *(unsigned*)((u16*)(p.ws + WS_K) + (size_t)grow * ATT + cb * 32 + c) = pack2(s0, s1);
    } else {
        u16* VT = (u16*)(p.ws + WS_VT);
        VT[(size_t)((cb - 16) * 32 + c) * MT + grow] = f2bf(s0);
        VT[(size_t)((cb - 16) * 32 + c + 1) * MT + grow] = f2bf(s1);
    }
}

DI void phase2(const Params& p, char* lds) {
    pg::DenseSched S; S.init(p.ws + WS_HM, p.ws + WS_WIN, L, PROJ, D);
    EpiP2 E{p.ws, lds + pg::STAGE_BYTES + 1024};
    pg::gemm_phase(( LAS unsigned char*)lds, D, S, E);
    for (int it = blockIdx.x; it < 256; it += gridDim.x) ctx_kv_item(p, it, lds);
}

DI bf16x8 pack8(float a0, float a1, float a2, float a3, float a4, float a5, float a6, float a7) {
    uint4 u = make_uint4(pack2(a0, a1), pack2(a2, a3), pack2(a4, a5), pack2(a6, a7));
    return __builtin_bit_cast(bf16x8, u);
}

constexpr int LROW = 144;
constexpr int VROW = 272;
constexpr int ATT_LK = 0, ATT_LV = 4 * 128 * LROW, ATT_LB = ATT_LV + 4 * 64 * VROW;

DI void attn_item_rh(int item, int& r, int& hq) {
    if (gridDim.x == 256) { const int c = item & 255; hq = item >> 8; r = 32 * (c & 7) + (c >> 3); }
    else { r = item >> 1; hq = item & 1; }
}
DI void attn_load(const Params& p, int item, int st, u32x4 (&rk)[8], u32x4 (&rv)[8]) {
    const int t = threadIdx.x;
    int r, hq; attn_item_rh(item, r, hq);
    const int rs = min(max(r - 4, 0), 256 - 8);
    const int tokbase = (st < 2) ? (L + st * 128) : ((rs + 2 * (st - 2)) * 64);
    const u16* Kb = (const u16*)(p.ws + WS_K); const u16* VT = (const u16*)(p.ws + WS_VT);
#pragma unroll
    for (int i = 0; i < 8; ++i) {
        const int c = t + NTH * i, hh = c >> 10, key = (c >> 3) & 127, ch = c & 7;
        rk[i] = *(const u32x4*)(Kb + (size_t)(tokbase + key) * ATT + (hq * 4 + hh) * 64 + ch * 8);
    }
#pragma unroll
    for (int i = 0; i < 8; ++i) {
        const int c = t + NTH * i, hh = c >> 10, d = (c >> 4) & 63, ch = c & 15;
        rv[i] = *(const u32x4*)(VT + (size_t)((hq * 4 + hh) * 64 + d) * MT + tokbase + ch * 8);
    }
}
DI void attn_store_lds(char* lds, const u32x4 (&rk)[8], const u32x4 (&rv)[8]) {
    const int t = threadIdx.x;
    char* lk = lds + ATT_LK; char* lv = lds + ATT_LV;
#pragma unroll
    for (int i = 0; i < 8; ++i) {
        const int c = t + NTH * i, hh = c >> 10, key = (c >> 3) & 127, ch = c & 7;
        *(u32x4*)(lk + (hh * 128 + key) * LROW + ch * 16) = rk[i];
    }
#pragma unroll
    for (int i = 0; i < 8; ++i) {
        const int c = t + NTH * i, hh = c >> 10, d = (c >> 4) & 63, ch = c & 15;
        char* rowp = lv + (hh * 64 + d) * VROW;
        *(uint2*)(rowp + (16 * (ch >> 1) + 4 * (ch & 1)) * 2) = make_uint2(rv[i].x, rv[i].y);
        *(uint2*)(rowp + (16 * (ch >> 1) + 8 + 4 * (ch & 1)) * 2) = make_uint2(rv[i].z, rv[i].w);
    }
}

template <int KIND>
DI void attn_sub(const char* lkrow, const char* lvrow, int vpos0, int vpos1, const float* btA, const float* btB, int kA, int kB,
                 int qc, int cs, int lh, const bf16x8 (&qf)[4], f32x16& o0, f32x16& o1, float& m, float& lsum) {
    f32x16 s;
#pragma unroll
    for (int i = 0; i < 16; ++i) s[i] = 0.f;
#pragma unroll
    for (int ks = 0; ks < 4; ++ks) {
        const bf16x8 kf = *(const bf16x8*)(lkrow + (ks * 2 + lh) * 16);
        s = MFMA(kf, qf[ks], s);
    }
    if (KIND == 1) {
        const float* pA = btA + (kA + 4 * lh - qc + 15);
        const float* pB = btB + (kB + 4 * lh - qc + 15);
        const int wA = kA + 4 * lh - cs, wB = kB + 4 * lh - cs;
        float bv[16];
#pragma unroll
        for (int i = 0; i < 16; ++i) bv[i] = ((i < 8) ? pA : pB)[(i & 3) + 8 * (i >> 2)];
#pragma unroll
        for (int i = 0; i < 16; ++i) {
            const bool valid = (unsigned)(((i < 8) ? wA : wB) + (i & 3) + 8 * (i >> 2)) < 16u;
            s[i] = valid ? (s[i] + bv[i]) : -1e30f;
        }
    }
    float tmax = s[0];
#pragma unroll
    for (int i = 1; i < 16; ++i) tmax = fmaxf(tmax, s[i]);
    if (!__all(tmax - m <= 8.f)) {
        tmax = fmaxf(tmax, __shfl_xor(tmax, 32));
        const float mnew = fmaxf(m, tmax);
        const float alpha = __builtin_amdgcn_exp2f(m - mnew);
        lsum *= alpha;
        m = mnew;
#pragma unroll
        for (int i = 0; i < 16; ++i) { o0[i] *= alpha; o1[i] *= alpha; }
    }
    float psum = 0.f;
#pragma unroll
    for (int i = 0; i < 16; ++i) { s[i] = __builtin_amdgcn_exp2f(s[i] - m); psum += s[i]; }
    lsum += psum;
#pragma unroll
    for (int j = 0; j < 2; ++j) {
        const bf16x8 pf = pack8(s[8 * j + 0], s[8 * j + 1], s[8 * j + 2], s[8 * j + 3], s[8 * j + 4], s[8 * j + 5], s[8 * j + 6], s[8 * j + 7]);
        const int vp = j ? vpos1 : vpos0;
        const bf16x8 v0 = *(const bf16x8*)(lvrow + (vp + 8 * lh) * 2);
        const bf16x8 v1 = *(const bf16x8*)(lvrow + 32 * VROW + (vp + 8 * lh) * 2);
        o0 = MFMA(v0, pf, o0);
        o1 = MFMA(v1, pf, o1);
    }
}

DI void attn_phase(const Params& p, char* lds) {
    const int t = threadIdx.x, lane = t & 63, w = t >> 6;
    const int hl = w >> 1, qh = w & 1;
    const int lr = lane & 31, lh = lane >> 5;
    const int qc = qh * 32 + lr;
    const int cs = min(max(qc - 8, 0), 48);
    const u16* Q = (const u16*)(p.ws + WS_Q);
    u16* YA = (u16*)(p.ws + WS_YATT);
    const char* lk = lds + ATT_LK; const char* lv = lds + ATT_LV; float* lbias = (float*)(lds + ATT_LB);
    constexpr int N_ATT = 512;
    int item = blockIdx.x;
    if (item >= N_ATT) return;
    u32x4 rk[8], rv[8];
    attn_load(p, item, 0, rk, rv);
    bf16x8 qf[4];
    f32x16 o0, o1;
    float m = -1e30f, lsum = 0.f;
    int st = 0;
    for (;;) {
        int r, hq; attn_item_rh(item, r, hq);
        const int head = hq * 4 + hl, tok = r * 64 + qc;
        const int rs = min(max(r - 4, 0), 256 - 8);
        __syncthreads();
        attn_store_lds(lds, rk, rv);
        if (st == 0) {
            for (int i = t; i < 4 * 465; i += NTH) lbias[i] = p.rpb[hq * 4 * 465 + i] * 1.44269504089f;
#pragma unroll
            for (int ks = 0; ks < 4; ++ks) qf[ks] = *(const bf16x8*)(Q + (size_t)tok * ATT + head * 64 + ks * 16 + lh * 8);
#pragma unroll
            for (int i = 0; i < 16; ++i) { o0[i] = 0.f; o1[i] = 0.f; }
            m = -1e30f; lsum = 0.f;
        }
        __syncthreads();
        int nitem = item, nst = st + 1;
        if (nst == 6) { nst = 0; nitem = item + gridDim.x; }
        const bool more = nitem < N_ATT;
        attn_load(p, more ? nitem : item, more ? nst : st, rk, rv);
        {
            const char* lkh = lk + hl * 128 * LROW;
            const char* lvrow = lv + (hl * 64 + lr) * VROW;
            if (st < 2) {
#pragma unroll 1
                for (int sub = 0; sub < 4; ++sub)
                    attn_sub<0>(lkh + (sub * 32 + lr) * LROW, lvrow, sub * 32, sub * 32 + 16, lbias, lbias, 0, 0, qc, cs, lh, qf, o0, o1, m, lsum);
            } else {
                const int g0 = rs + 2 * (st - 2);
                const float* bt0 = lbias + hl * 465 + (g0 - r + 7) * 31;
                const float* bt1 = bt0 + 31;
                const int fb = qh * 32;
                const int cb = qh ? 16 : 32;
                attn_sub<1>(lkh + (fb + lr) * LROW, lvrow, fb, fb + 16, bt0, bt0, fb, fb, qc, cs, lh, qf, o0, o1, m, lsum);
                attn_sub<1>(lkh + (64 + fb + lr) * LROW, lvrow, 64 + fb, 64 + fb + 16, bt1, bt1, fb, fb, qc, cs, lh, qf, o0, o1, m, lsum);
                attn_sub<1>(lkh + (((lr < 16) ? cb : 48 + cb) + lr) * LROW, lvrow, cb, 64 + cb, bt0, bt1, cb, cb - 16, qc, cs, lh, qf, o0, o1, m, lsum);
            }
        }
        if (st == 5) {
            const float inv = 1.f / (lsum + __shfl_xor(lsum, 32));
#pragma unroll
            for (int q = 0; q < 4; ++q) {
                const int d0 = q * 8 + lh * 4;
                *(uint2*)(YA + (size_t)tok * ATT + head * 64 + d0) =
                    make_uint2(pack2(o0[q * 4] * inv, o0[q * 4 + 1] * inv), pack2(o0[q * 4 + 2] * inv, o0[q * 4 + 3] * inv));
                *(uint2*)(YA + (size_t)tok * ATT + head * 64 + 32 + d0) =
                    make_uint2(pack2(o1[q * 4] * inv, o1[q * 4 + 1] * inv), pack2(o1[q * 4 + 2] * inv, o1[q * 4 + 3] * inv));
            }
        }
        if (!more) break;
        item = nitem; st = nst;
    }
    __syncthreads();
}

DI void pool_item(const Params& p, int pt, char* lds) {
    const int tok0 = pt * 64;
    const u16* PLb = (const u16*)(p.ws + WS_POOL);
    __syncthreads();
    for (int c = threadIdx.x; c < 80 * 64; c += NTH) {
        const int row = c >> 6, ch = c & 63, tt = tok0 - 8 + row;
        u32x4 v = (u32x4){0u, 0u, 0u, 0u};
        if (tt >= 0 && tt < L) v = *(const u32x4*)(PLb + (size_t)tt * ATT + ch * 8);
        *(u32x4*)(lds + row * 1024 + ch * 16) = v;
    }
    __syncthreads();
    const int t = threadIdx.x & 255, th = threadIdx.x >> 8;
    const unsigned* lp = (const unsigned*)lds;
    unsigned* PD = (unsigned*)(p.ws + WS_POOLED);
    const int g = t >> 6;
    const int half = 1 << g;
    const int tl0 = th * 32;
    float s0 = 0.f, s1 = 0.f;
    for (int k = -half; k < half; ++k) { const unsigned u = lp[(tl0 + k + 8) * 256 + t]; s0 += bflo(u); s1 += bfhi(u); }
#pragma unroll 8
    for (int i = 0; i < 32; ++i) {
        const int tl = tl0 + i, tok = tok0 + tl;
        const int lo = max(tok - half, 0), hi = min(tok + half, L);
        const float invn = 1.f / (float)(hi - lo);
        const unsigned u = lp[(tl + 8) * 256 + t];
        PD[(size_t)tok * 256 + t] = pack2(s0 * invn - bflo(u), s1 * invn - bfhi(u));
        const unsigned ua = lp[(tl + half + 8) * 256 + t], ud = lp[(tl - half + 8) * 256 + t];
        s0 += bflo(ua) - bflo(ud); s1 += bfhi(ua) - bfhi(ud);
    }
}

DI void phase3(const Params& p, char* lds) {
    attn_phase(p, lds);
    for (int it = blockIdx.x; it < 256; it += gridDim.x) pool_item(p, it, lds);
}

template <int PASS> struct EpiP4 {
    static constexpr bool PERM = true;
    unsigned char* ws;
    DI void operator()(const f32x4 (&acc)[2][2][4][2], const pg::Unit& u, int wr, int wc, int fr, int fq) const {
        const u16* G = (const u16*)(ws + (PASS == 0 ? WS_SA : WS_SB));
        u16* Z = (u16*)(ws + WS_Z);
        const int row0 = u.pm * 256 + wr * 64 + fr;
#pragma unroll
        for (int ai = 0; ai < 2; ++ai)
#pragma unroll
            for (int m = 0; m < 4; ++m)
#pragma unroll
                for (int bj = 0; bj < 2; ++bj) {
                    const size_t o = (size_t)(row0 + ai * 128 + m * 16) * D + u.pn * 256 + bj * 128 + wc * 32 + 8 * fq;
                    const u32x4 g = __builtin_nontemporal_load((const u32x4*)(G + o));
                    f32x4 v0 = acc[ai][bj][m][0], v1 = acc[ai][bj][m][1];
                    v0[0] *= bflo(g.x); v0[1] *= bfhi(g.x); v0[2] *= bflo(g.y); v0[3] *= bfhi(g.y);
                    v1[0] *= bflo(g.z); v1[1] *= bfhi(g.z); v1[2] *= bflo(g.w); v1[3] *= bfhi(g.w);
                    if (PASS == 1) {
                        const u32x4 z = *(const u32x4*)(Z + o);
                        v0[0] += bflo(z.x); v0[1] += bfhi(z.x); v0[2] += bflo(z.y); v0[3] += bfhi(z.y);
                        v1[0] += bflo(z.z); v1[1] += bfhi(z.z); v1[2] += bflo(z.w); v1[3] += bfhi(z.w);
                    }
                    *(u32x4*)(Z + o) = pack8v(v0, v1);
                }
    }
};

DI void phase4(const Params& p, char* lds) {
    { pg::DenseSched S; S.init(p.ws + WS_YATT, p.ws + WS_WA, L, D, ATT); EpiP4<0> E{p.ws}; pg::gemm_phase((LAS unsigned char*)lds, ATT, S, E); }
    { pg::DenseSched S; S.init(p.ws + WS_POOLED, p.ws + WS_WPC, L, D, ATT); EpiP4<1> E{p.ws}; pg::gemm_phase((LAS unsigned char*)lds, ATT, S, E); }
}

struct EpiP5 {
    static constexpr bool PERM = true;
    DI bool keep(const pg::Unit&) const { return false; }
    u16* Y;
    DI void operator()(f32x4 (&acc)[2][2][4][2], const pg::Unit& u, int wr, int wc, int fr, int fq) const {
        const int row0 = u.pm * 256 + wr * 64 + fr, col0 = u.pn * 256 + wc * 32 + 8 * fq;
#pragma unroll
        for (int ai = 0; ai < 2; ++ai)
#pragma unroll
            for (int m = 0; m < 4; ++m) {
                u16* rowp = Y + (size_t)(row0 + ai * 128 + m * 16) * D + col0;
#pragma unroll
                for (int bj = 0; bj < 2; ++bj) *(u32x4*)(rowp + bj * 128) = pack8v(acc[ai][bj][m][0], acc[ai][bj][m][1]);
            }
    }
};

DI void phase5(const Params& p, char* lds) {
    pg::DenseSched S; S.init(p.ws + WS_Z, p.ws + WS_WOUT, L, D, D);
    EpiP5 E{(u16*)(p.ws + WS_HM2)};
    pg::gemm_phase((LAS unsigned char*)lds, D, S, E);
}

DI void phase6(const Params& p, char* lds) {
    float* lm = (float*)lds;
    load_modvec(lm, p, 0, 2); load_modvec(lm + 1024, p, 0, 3); load_modvec(lm + 2048, p, 0, 4);
    __syncthreads();
    const int lane = threadIdx.x & 63, w = threadIdx.x >> 6;
    float* Y = (float*)(p.ws + WS_Y);
    u16* HM2 = (u16*)(p.ws + WS_HM2);
    const float* wrt = (const float*)(p.ws + WS_WRT);
    int* cnt = (int*)(p.ws + WS_CNT); int* list = (int*)(p.ws + WS_LIST); float* cw = (float*)(p.ws + WS_CW);
    int4* tinfo = (int4*)(p.ws + WS_TINFO);
    int* lcnt = (int*)(lds + 12288); int* lbase = lcnt + 32; int* recE = lbase + 32; int* recP = recE + 128; float* recC = (float*)(recP + 128);
    float* lwre = (float*)(lds + 16384);
    for (int i = threadIdx.x; i < 32 * 256; i += NTH) *(float4*)(lwre + i * 4) = *(const float4*)(wrt + 4 * 1024 + i * 4);
    for (int tb = blockIdx.x; tb < L / 64; tb += gridDim.x) {
    __syncthreads();
    if (threadIdx.x < 32) lcnt[threadIdx.x] = 0;
    __syncthreads();
    for (int tp = 0; tp < 4; ++tp) {
        constexpr int NB = 2;
        const int tl0 = w * 8 + tp * NB, row0 = tb * 64 + tl0;
        float4 v[NB][4], y[NB][4];
#pragma unroll
        for (int r = 0; r < NB; ++r)
#pragma unroll
            for (int j = 0; j < 4; ++j) {
                { const f32x4 xv = __builtin_nontemporal_load((const f32x4*)(p.x + (size_t)(row0 + r) * D + (j * 64 + lane) * 4)); v[r][j] = make_float4(xv[0], xv[1], xv[2], xv[3]); }
                { const u32x2 ybv = __builtin_nontemporal_load((const u32x2*)(HM2 + (size_t)(row0 + r) * D + (j * 64 + lane) * 4)); const uint2 yb = make_uint2(ybv[0], ybv[1]);
                  y[r][j] = make_float4(bflo(yb.x), bfhi(yb.x), bflo(yb.y), bfhi(yb.y)); }
            }
        ln_rows<NB>(v, p.ln_in_g, p.ln_in_b, lane);
#pragma unroll
        for (int j = 0; j < 4; ++j) {
            const float4 g1 = *(const float4*)(lm + (j * 64 + lane) * 4);
#pragma unroll
            for (int r = 0; r < NB; ++r) {
                v[r][j].x = ALPHA * v[r][j].x + g1.x * y[r][j].x; v[r][j].y = ALPHA * v[r][j].y + g1.y * y[r][j].y;
                v[r][j].z = ALPHA * v[r][j].z + g1.z * y[r][j].z; v[r][j].w = ALPHA * v[r][j].w + g1.w * y[r][j].w;
            }
        }
        ln_rows<NB>(v, p.ln1_g, p.ln1_b, lane);
#pragma unroll
        for (int j = 0; j < 4; ++j) {
            const int e = (j * 64 + lane) * 4;
            const float4 s4 = *(const float4*)(lm + 1024 + e), c4 = *(const float4*)(lm + 2048 + e);
#pragma unroll
            for (int r = 0; r < NB; ++r) {
                { const f32x4 hv = {v[r][j].x, v[r][j].y, v[r][j].z, v[r][j].w}; __builtin_nontemporal_store(hv, (f32x4*)(Y + (size_t)(row0 + r) * D + e)); }
                v[r][j].x = v[r][j].x * (1.f + c4.x) + s4.x; v[r][j].y = v[r][j].y * (1.f + c4.y) + s4.y;
                v[r][j].z = v[r][j].z * (1.f + c4.z) + s4.z; v[r][j].w = v[r][j].w * (1.f + c4.w) + s4.w;
                *(uint2*)(HM2 + (size_t)(row0 + r) * D + e) = make_uint2(pack2(v[r][j].x, v[r][j].y), pack2(v[r][j].z, v[r][j].w));
            }
        }
        const bool h5 = lane & 32, h4 = lane & 16, h3 = lane & 8;
        float cg[NB];
#pragma unroll
        for (int r = 0; r < NB; ++r) {
            float sp[4];
#pragma unroll
            for (int g = 0; g < 4; ++g) sp[g] = 0.f;
#pragma unroll
            for (int j = 0; j < 4; ++j)
#pragma unroll
                for (int g = 0; g < 4; ++g) {
                    const float4 wv = *(const float4*)(wrt + g * 1024 + (j * 64 + lane) * 4);
                    sp[g] += v[r][j].x * wv.x + v[r][j].y * wv.y + v[r][j].z * wv.z + v[r][j].w * wv.w;
                }
            const float a0 = (h5 ? sp[2] : sp[0]) + __shfl_xor(h5 ? sp[0] : sp[2], 32);
            const float a1 = (h5 ? sp[3] : sp[1]) + __shfl_xor(h5 ? sp[1] : sp[3], 32);
            cg[r] = (h4 ? a1 : a0) + __shfl_xor(h4 ? a0 : a1, 16);
        }
        int gsel[NB]; float pg[NB];
#pragma unroll
        for (int r = 0; r < NB; ++r) {
            const float c = row_sum16(cg[r]);
            float lg[4];
#pragma unroll
            for (int g = 0; g < 4; ++g) lg[g] = rl(c, 16 * g) + p.b_rg[g];
            int gs = 0; float gmax = lg[0];
#pragma unroll
            for (int g = 1; g < 4; ++g) if (lg[g] > gmax) { gmax = lg[g]; gs = g; }
            float gden = 0.f;
#pragma unroll
            for (int g = 0; g < 4; ++g) gden += __expf(lg[g] - gmax);
            gsel[r] = gs; pg[r] = 1.f / gden;
        }
        float ce[NB];
#pragma unroll
        for (int r = 0; r < NB; ++r) {
            float sp[8];
            const float* wp0 = lwre + gsel[r] * 8 * 1024;
#pragma unroll
            for (int e = 0; e < 8; ++e) {
                float s_ = 0.f;
#pragma unroll
                for (int j = 0; j < 4; ++j) {
                    const float4 wv = *(const float4*)(wp0 + e * 1024 + (j * 64 + lane) * 4);
                    s_ += v[r][j].x * wv.x + v[r][j].y * wv.y + v[r][j].z * wv.z + v[r][j].w * wv.w;
                }
                sp[e] = s_;
            }
            float a[4];
#pragma unroll
            for (int i = 0; i < 4; ++i) a[i] = (h5 ? sp[4 + i] : sp[i]) + __shfl_xor(h5 ? sp[i] : sp[4 + i], 32);
            const float b0 = (h4 ? a[2] : a[0]) + __shfl_xor(h4 ? a[0] : a[2], 16);
            const float b1 = (h4 ? a[3] : a[1]) + __shfl_xor(h4 ? a[1] : a[3], 16);
            float c = (h3 ? b1 : b0) + dpp_f<0x140>(h3 ? b0 : b1);
            c += dpp_f<0xB1>(c); c += dpp_f<0x4E>(c); c += dpp_f<0x141>(c);
            ce[r] = c;
        }
#pragma unroll
        for (int r = 0; r < NB; ++r) {
            float le[8];
#pragma unroll
            for (int e = 0; e < 8; ++e) le[e] = rl(ce[r], (e >> 2) * 32 + ((e >> 1) & 1) * 16 + (e & 1) * 8) + p.b_re[gsel[r] * 8 + e];
            int e1 = 0; float l1 = le[0];
#pragma unroll
            for (int e = 1; e < 8; ++e) if (le[e] > l1) { l1 = le[e]; e1 = e; }
            int e2 = -1; float l2 = -3.0e38f;
#pragma unroll
            for (int e = 0; e < 8; ++e) if (e != e1 && le[e] > l2) { l2 = le[e]; e2 = e; }
            const float ex = __expf(l2 - l1);
            const float c1 = pg[r] / (1.f + ex), c2 = pg[r] * ex / (1.f + ex);
            if (lane == 0) {
                const int tl = tl0 + r;
                const int E1 = gsel[r] * 8 + e1, E2 = gsel[r] * 8 + e2;
                recE[tl * 2] = E1; recE[tl * 2 + 1] = E2;
                recP[tl * 2] = atomicAdd(&lcnt[E1], 1); recP[tl * 2 + 1] = atomicAdd(&lcnt[E2], 1);
                recC[tl * 2] = c1; recC[tl * 2 + 1] = c2;
            }
        }
    }
    __syncthreads();
    if (threadIdx.x < 32) { const int n = lcnt[threadIdx.x]; lbase[threadIdx.x] = n ? atomicAdd(&cnt[threadIdx.x * 64], n) : 0; }
    __syncthreads();
    if (threadIdx.x < 64) {
        const int tl = threadIdx.x, row = tb * 64 + tl;
        const int E1 = recE[tl * 2], E2 = recE[tl * 2 + 1];
        const int p1 = lbase[E1] + recP[tl * 2], p2 = lbase[E2] + recP[tl * 2 + 1];
        list[E1 * CAP + p1] = row; cw[E1 * CAP + p1] = recC[tl * 2];
        list[E2 * CAP + p2] = row; cw[E2 * CAP + p2] = recC[tl * 2 + 1];
        tinfo[row] = make_int4(E1, p1, E2, p2);
    }
    }
}

DI void build_offsets(const Params& p, int* loff, int* ltoff) {
    const int* cnt = (const int*)(p.ws + WS_CNT);
    int* lc = ltoff + 40;
    __syncthreads();
    if (threadIdx.x < NE) lc[threadIdx.x] = cnt[threadIdx.x * 64];
    __syncthreads();
    if (threadIdx.x == 0) {
        int o = 0, to = 0;
        for (int e = 0; e < NE; ++e) { loff[e] = o; ltoff[e] = to; const int c = lc[e]; o += c; to += (c + 255) >> 8; }
        loff[NE] = o; ltoff[NE] = to;
    }
    __syncthreads();
}

struct MoeSched {
    const char* A; const char* W; size_t wstride; int K, mode;
    const int* cnt; const int* list; const int* loff; const int* ltoff;
    int G, c, nunits;
    DI bool next(int i, pg::Unit& u, const int (&R)[2], const int (&C)[2]) const {
        int e, tl, pn;
        if (G == 256) {
            int j = i * 32 + (c >> 3), q = 0;
            e = c & 7;
            for (; q < 4; ++q) {
                const int nu = __builtin_amdgcn_readfirstlane((ltoff[e + 1] - ltoff[e]) * 4);
                if (j < nu) break;
                j -= nu; e += 8;
            }
            if (q == 4) return false;
            tl = j >> 2; pn = j & 3;
        } else {
            const int Lx = i * G + c; if (Lx >= nunits) return false;
            const int gt = Lx >> 2; pn = Lx & 3;
            e = 0;
            while (e < NE - 1 && ltoff[e + 1] <= gt) ++e;
            tl = gt - ltoff[e];
        }
        u.e = e; u.tl = tl; u.cnt = cnt[e * 64]; u.pm = u.tl; u.pn = pn;
        u.A = A; u.B = W + (size_t)e * wstride + (size_t)pn * 256 * K * 2;
#pragma unroll
        for (int h = 0; h < 2; ++h)
#pragma unroll
            for (int j = 0; j < 2; ++j) {
                int idx = u.tl * 256 + h * 128 + R[j];
                if (idx >= u.cnt) idx = u.cnt - 1;
                const int row = (mode == 0) ? list[e * CAP + idx] : (loff[e] + idx);
                u.ao[h][j] = (unsigned)(row * K + C[j]) * 2u;
            }
        return true;
    }
};

struct EpiP7 {
    static constexpr bool PERM = true;
    unsigned char* ws; const int* loff;
    template <bool CHECK>
    DI void body(const f32x4 (&acc)[2][2][4][2], const pg::Unit& u, int wr, int wc, int fr, int fq) const {
        const int idx0 = u.tl * 256 + wr * 64 + fr;
        const float* cw = (const float*)(ws + WS_CW) + (size_t)u.e * CAP + idx0;
        u16* ACT = (u16*)(ws + WS_ACT) + (size_t)(loff[u.e] + idx0) * DE + u.pn * 128 + wc * 32 + 8 * fq;
        float cwv[2][4];
#pragma unroll
        for (int ai = 0; ai < 2; ++ai)
#pragma unroll
            for (int m = 0; m < 4; ++m) cwv[ai][m] = (!CHECK || idx0 + ai * 128 + m * 16 < u.cnt) ? cw[ai * 128 + m * 16] : 0.f;
#pragma unroll
        for (int ai = 0; ai < 2; ++ai)
#pragma unroll
            for (int m = 0; m < 4; ++m) {
                f32x4 o0, o1;
#pragma unroll
                for (int j = 0; j < 4; ++j) {
                    o0[j] = siluf_(acc[ai][0][m][0][j]) * acc[ai][1][m][0][j] * cwv[ai][m];
                    o1[j] = siluf_(acc[ai][0][m][1][j]) * acc[ai][1][m][1][j] * cwv[ai][m];
                }
                if (!CHECK || idx0 + ai * 128 + m * 16 < u.cnt) *(u32x4*)(ACT + (size_t)(ai * 128 + m * 16) * DE) = pack8v(o0, o1);
            }
    }
    DI void operator()(const f32x4 (&acc)[2][2][4][2], const pg::Unit& u, int wr, int wc, int fr, int fq) const {
        if (u.tl * 256 + 256 <= u.cnt) body<false>(acc, u, wr, wc, fr, fq);
        else body<true>(acc, u, wr, wc, fr, fq);
    }
};

DI void phase7(const Params& p, char* lds) {
    int* loff = (int*)(lds + pg::STAGE_BYTES); int* ltoff = loff + 40;
    build_offsets(p, loff, ltoff);
    MoeSched S; S.A = (const char*)(p.ws + WS_HM2); S.W = (const char*)(p.ws + WS_WGU); S.wstride = (size_t)1024 * D * 2; S.K = D; S.mode = 0;
    S.cnt = (const int*)(p.ws + WS_CNT); S.list = (const int*)(p.ws + WS_LIST); S.loff = loff; S.ltoff = ltoff;
    S.G = gridDim.x; S.c = blockIdx.x; S.nunits = ltoff[NE] * 4;
    EpiP7 E{p.ws, loff};
    pg::gemm_phase((LAS unsigned char*)lds, D, S, E);
    {
        int* qhead = (int*)(p.ws + WS_CNT) + 32 * 64;
        int* lq = ltoff + 80;
        float* lt = (float*)lds; float* lt0 = lt; float* lt1 = lt + 2 * 64 * 65;
        for (;;) {
            __syncthreads();
            if (threadIdx.x == 0) lq[0] = atomicAdd(qhead, 2);
            __syncthreads();
            const int q = lq[0];
            if (q >= TP_DN) break;
            const TpDesc da = tp_decode(p, TP_TOTAL - TP_DN + q), db = tp_decode(p, TP_TOTAL - TP_DN + q + 1);
            f32x4 ra[4], rb[4];
            tp_load(da, ra); tp_load(db, rb);
            tp_to_lds(lt0, ra); tp_to_lds(lt1, rb);
            __syncthreads();
            tp_store(lt0, da); tp_store(lt1, db);
        }
    }
}

struct EpiP8 {
    static constexpr bool PERM = true;
    unsigned char* ws; const int* loff;
    template <bool CHECK>
    DI void body(const f32x4 (&acc)[2][2][4][2], const pg::Unit& u, int wr, int wc, int fr, int fq) const {
        const int idx0 = u.tl * 256 + wr * 64 + fr;
        u16* rowp = (u16*)(ws + WS_OUTP) + (size_t)(loff[u.e] + idx0) * D + u.pn * 256 + wc * 32 + 8 * fq;
#pragma unroll
        for (int ai = 0; ai < 2; ++ai)
#pragma unroll
            for (int m = 0; m < 4; ++m)
                if (!CHECK || idx0 + ai * 128 + m * 16 < u.cnt) {
#pragma unroll
                    for (int bj = 0; bj < 2; ++bj) *(u32x4*)(rowp + (size_t)(ai * 128 + m * 16) * D + bj * 128) = pack8v(acc[ai][bj][m][0], acc[ai][bj][m][1]);
                }
    }
    DI void operator()(const f32x4 (&acc)[2][2][4][2], const pg::Unit& u, int wr, int wc, int fr, int fq) const {
        if (u.tl * 256 + 256 <= u.cnt) body<false>(acc, u, wr, wc, fr, fq);
        else body<true>(acc, u, wr, wc, fr, fq);
    }
};

DI void phase8(const Params& p, char* lds) {
    int* loff = (int*)(lds + pg::STAGE_BYTES); int* ltoff = loff + 40;
    build_offsets(p, loff, ltoff);
    MoeSched S; S.A = (const char*)(p.ws + WS_ACT); S.W = (const char*)(p.ws + WS_WDN); S.wstride = (size_t)D * DE * 2; S.K = DE; S.mode = 1;
    S.cnt = (const int*)(p.ws + WS_CNT); S.list = (const int*)(p.ws + WS_LIST); S.loff = loff; S.ltoff = ltoff;
    S.G = gridDim.x; S.c = blockIdx.x; S.nunits = ltoff[NE] * 4;
    EpiP8 E{p.ws, loff};
    pg::gemm_phase((LAS unsigned char*)lds, DE, S, E);
}

DI void phase9(const Params& p, char* lds) {
    float* lm = (float*)lds;
    int* loff = (int*)(lds + 4096); int* ltoff = loff + 40;
    load_modvec(lm, p, 0, 5);
    build_offsets(p, loff, ltoff);
    const int lane = threadIdx.x & 63, w = threadIdx.x >> 6;
    const float* H1 = (const float*)(p.ws + WS_Y);
    const u16* OUTP = (const u16*)(p.ws + WS_OUTP);
    const int4* tinfo = (const int4*)(p.ws + WS_TINFO);
    for (int row0 = (blockIdx.x * NWV + w) * 4; row0 < L; row0 += gridDim.x * NWV * 4) {
        float4 v[4][4];
#pragma unroll
        for (int r = 0; r < 4; ++r) {
            const int row = row0 + r;
            const int4 ti = tinfo[row];
            const u16* r1 = OUTP + (size_t)(loff[ti.x] + ti.y) * D;
            const u16* r2 = OUTP + (size_t)(loff[ti.z] + ti.w) * D;
#pragma unroll
            for (int j = 0; j < 4; ++j) {
                const int e = (j * 64 + lane) * 4;
                const f32x4 hv = __builtin_nontemporal_load((const f32x4*)(H1 + (size_t)row * D + e));
                const float4 h = make_float4(hv[0], hv[1], hv[2], hv[3]);
                const u32x2 av = __builtin_nontemporal_load((const u32x2*)(r1 + e)), bv2 = __builtin_nontemporal_load((const u32x2*)(r2 + e));
                const uint2 a = make_uint2(av[0], av[1]), b = make_uint2(bv2[0], bv2[1]);
                const float4 g2 = *(const float4*)(lm + e);
                v[r][j].x = ALPHA * h.x + g2.x * (bflo(a.x) + bflo(b.x));
                v[r][j].y = ALPHA * h.y + g2.y * (bfhi(a.x) + bfhi(b.x));
                v[r][j].z = ALPHA * h.z + g2.z * (bflo(a.y) + bflo(b.y));
                v[r][j].w = ALPHA * h.w + g2.w * (bfhi(a.y) + bfhi(b.y));
            }
        }
        ln_rows<4>(v, p.ln2_g, p.ln2_b, lane);
#pragma unroll
        for (int r = 0; r < 4; ++r)
#pragma unroll
            for (int j = 0; j < 4; ++j) { const f32x4 ov = {v[r][j].x, v[r][j].y, v[r][j].z, v[r][j].w}; __builtin_nontemporal_store(ov, (f32x4*)(p.out + (size_t)(row0 + r) * D + (j * 64 + lane) * 4)); }
    }
}

#define XB_TMO      128
#define XB_XCNT(j)  (256  + 64 * (j))
#define XB_XSUB(j)  (1280 + 64 * (j))
#define XB_XGEN(j)  (2304 + 64 * (j))
#define XB_TOP      3328
#define XB_TOPGEN   3392
#define XCD_BAR_WORDS 3456
#define XB_SPIN_CAP (1u << 18)
DI unsigned xb_ld(unsigned* p)              { return __hip_atomic_load(p, __ATOMIC_RELAXED, __HIP_MEMORY_SCOPE_AGENT); }
DI unsigned xb_add(unsigned* p, unsigned v) { return __hip_atomic_fetch_add(p, v, __ATOMIC_RELAXED, __HIP_MEMORY_SCOPE_AGENT); }
DI unsigned xb_xcc_id() { return (unsigned)__builtin_amdgcn_s_getreg((3 << 11) | 20) & 0xFu; }
#define XB_SPIN(cond, bar) do { unsigned _sp = 0; while (cond) { __builtin_amdgcn_s_sleep(1); \
    if ((++_sp & 255u) == 0u) { if (xb_ld(&(bar)[XB_TMO])) break; if (_sp > XB_SPIN_CAP) { atomicAdd(&(bar)[XB_TMO], 1u); break; } } } } while (0)
struct XcdBarrier { unsigned* bar; unsigned x; volatile LAS unsigned* st; };
DI XcdBarrier xcd_barrier_post(unsigned* bar, volatile LAS unsigned* st) {
    XcdBarrier b; b.bar = bar; b.x = xb_xcc_id(); b.st = st;
    if (threadIdx.x == 0) (void)xb_add(&bar[XB_XCNT(b.x)], 1u);
    return b;
}
DI void xcd_barrier_complete(unsigned* bar, unsigned x, unsigned& nloc, unsigned& nx) {
    const unsigned G = gridDim.x * gridDim.y * gridDim.z;
    unsigned sum, cnt, mine, sp = 0u;
    for (;;) {
        sum = 0u; cnt = 0u; mine = 0u;
#pragma unroll
        for (unsigned j = 0; j < 16; ++j) { const unsigned c = xb_ld(&bar[XB_XCNT(j)]); sum += c; cnt += (c > 0u) ? 1u : 0u; mine = (j == x) ? c : mine; }
        if (sum == G) break;
        __builtin_amdgcn_s_sleep(1);
        if ((++sp & 255u) == 0u) { if (xb_ld(&bar[XB_TMO])) break; if (sp > XB_SPIN_CAP) { atomicAdd(&bar[XB_TMO], 1u); break; } }
    }
    nloc = mine > 0u ? mine : 1u; nx = cnt > 0u ? cnt : 1u;
}
DI void xcd_barrier(const XcdBarrier& b) {
    asm volatile("s_waitcnt vmcnt(0)" ::: "memory");
    __syncthreads();
    if (threadIdx.x == 0) {
        unsigned* bar = b.bar;
        __builtin_amdgcn_s_waitcnt(0);
        unsigned nloc = b.st[0], nx = b.st[1];
        if (nloc == 0u) { xcd_barrier_complete(bar, b.x, nloc, nx); b.st[0] = nloc; b.st[1] = nx; }
        const unsigned old = xb_add(&bar[XB_XSUB(b.x)], 1u);
        const unsigned gen = old / nloc;
        if (old + 1u == (gen + 1u) * nloc) {
            __builtin_amdgcn_fence(__ATOMIC_RELEASE, "agent");
            asm volatile("s_waitcnt vmcnt(0)" ::: "memory");
            const unsigned og = xb_add(&bar[XB_TOP], 1u);
            const unsigned tg = og / nx;
            if (og + 1u == (tg + 1u) * nx) xb_add(&bar[XB_TOPGEN], 1u);
            else XB_SPIN(xb_ld(&bar[XB_TOPGEN]) == tg, bar);
            __builtin_amdgcn_fence(__ATOMIC_ACQUIRE, "agent");
            xb_add(&bar[XB_XGEN(b.x)], 1u);
            asm volatile("s_waitcnt vmcnt(0)" ::: "memory");
        } else {
            XB_SPIN(xb_ld(&bar[XB_XGEN(b.x)]) == gen, bar);
            __builtin_amdgcn_fence(__ATOMIC_ACQUIRE, "agent");
            asm volatile("s_waitcnt vmcnt(0)" ::: "memory");
        }
    }
    __syncthreads();
}

extern __shared__ __attribute__((aligned(16))) char dyn_lds[];
constexpr int LDS_TOTAL = 152576;

__global__ void __launch_bounds__(512, 2) fwd_mega(Params p) {
    cg::grid_group grid = cg::this_grid();
    char* lds = dyn_lds;
    __shared__ uint4 xb_words;
    if (threadIdx.x == 0) xb_words = make_uint4(0u, 0u, 0u, 0u);
    __syncthreads();
    XcdBarrier xb = xcd_barrier_post((unsigned*)(p.ws + WS_BAR), (volatile LAS unsigned*)&xb_words);
    if (p.ph_hi > 1000) grid.sync();
#ifndef DUP_MASK
#define DUP_MASK 0
#endif
#define RUN_PHASE(n) if (p.ph_lo <= n && n < p.ph_hi) { phase##n(p, lds); if ((DUP_MASK >> n) & 1) { xcd_barrier(xb); phase##n(p, lds); } if (n + 1 < p.ph_hi) xcd_barrier(xb); }
    if (p.ph_lo <= 0 && 0 < p.ph_hi) { phase0(p, lds); if (p.ph_hi == 1) {} }
    RUN_PHASE(1) RUN_PHASE(2) RUN_PHASE(3) RUN_PHASE(4)
    RUN_PHASE(5) RUN_PHASE(6) RUN_PHASE(7) RUN_PHASE(8) RUN_PHASE(9)
#undef RUN_PHASE
}

extern "C" void kernel_launch(void* const* d_in, const int* in_sizes, int n_in, void* d_out, int out_size, void* d_ws, size_t ws_size, hipStream_t stream) {
    static int grid_blocks = 0;
    if (!grid_blocks) {
        int dev = 0, cus = 0, per_cu = 0;
        hipGetDevice(&dev);
        hipDeviceGetAttribute(&cus, hipDeviceAttributeMultiprocessorCount, dev);
        hipFuncSetAttribute((const void*)fwd_mega, hipFuncAttributeMaxDynamicSharedMemorySize, LDS_TOTAL);
        hipOccupancyMaxActiveBlocksPerMultiprocessor(&per_cu, (const void*)fwd_mega, NTH, LDS_TOTAL);
        if (per_cu < 1) per_cu = 1;
        if (per_cu > 1) per_cu = 1;
        grid_blocks = cus * per_cu;
        if (ws_size < WS_END) fprintf(stderr, "kernel_launch: workspace too small: %zu < %zu\n", ws_size, (size_t)WS_END);
    }
    Params p{};
    const float** pf = (const float**)&p;
    for (int i = 0; i < 26; ++i) pf[i] = (const float*)d_in[i];
    p.out = (float*)d_out;
    p.ws = (unsigned char*)d_ws;
#if N_LAUNCH_MODE == 1
    (void)hipMemsetAsync((char*)d_ws + WS_BAR, 0, XCD_BAR_WORDS * 4, stream);
    p.ph_lo = 0; p.ph_hi = NPHASE;
    void* args[] = {&p};
    hipError_t e = hipLaunchCooperativeKernel((const void*)fwd_mega, dim3(grid_blocks), dim3(NTH), args, LDS_TOTAL, stream);
    if (e != hipSuccess) fprintf(stderr, "cooperative launch failed: %s (grid %d)\n", hipGetErrorString(e), grid_blocks);
#else
    for (int ph = 0; ph < NPHASE; ++ph) {
        p.ph_lo = ph; p.ph_hi = ph + 1;
        hipLaunchKernelGGL(fwd_mega, dim3(grid_blocks), dim3(NTH), LDS_TOTAL, stream, p);
#ifdef PROBE_DUP
        if (ph == PROBE_DUP) hipLaunchKernelGGL(fwd_mega, dim3(grid_blocks), dim3(NTH), LDS_TOTAL, stream, p);
#endif
    }
#endif
}
```

```cpp
#include <hip/hip_runtime.h>
#include <hip/hip_cooperative_groups.h>
#include <cstdio>
namespace cg = cooperative_groups;

#ifndef N_LAUNCH_MODE
#define N_LAUNCH_MODE 1
#endif

typedef unsigned short u16;
typedef __attribute__((ext_vector_type(8))) short bf16x8;
typedef __attribute__((ext_vector_type(16))) float f32x16;
#define DI __device__ __forceinline__
#define MFMA(a, b, c) __builtin_amdgcn_mfma_f32_32x32x16_bf16((a), (b), (c), 0, 0, 0)

constexpr int D = 1024, L = 16384, CTX = 256, MT = L + CTX;
constexpr int ATT = 512, PROJ = 4096;
constexpr int NE = 32, DE = 512, CAP = 16384;
constexpr float ALPHA = 1.189207115002721f;
constexpr float LN_EPS = 1e-5f;
constexpr int NPHASE = 10;
constexpr int NTH = 512, NWV = 8;

constexpr size_t al(size_t x) { return (x + 255) & ~(size_t)255; }
constexpr size_t WS_WIN   = 0;
constexpr size_t WS_WA    = WS_WIN  + al((size_t)PROJ * D * 2);
constexpr size_t WS_WPC   = WS_WA   + al((size_t)D * ATT * 2);
constexpr size_t WS_WOUT  = WS_WPC  + al((size_t)D * ATT * 2);
constexpr size_t WS_WGU   = WS_WOUT + al((size_t)D * D * 2);
constexpr size_t WS_WDN   = WS_WGU  + al((size_t)NE * 1024 * D * 2);
constexpr size_t WS_WRT   = WS_WDN  + al((size_t)NE * D * DE * 2);
constexpr size_t WS_MODP  = WS_WRT  + al((size_t)36 * D * 4);
constexpr size_t WS_CNT   = WS_MODP + al((size_t)16 * 2 * 6144 * 4);
constexpr size_t WS_LIST  = WS_CNT  + 64 * 256;
constexpr size_t WS_CW    = WS_LIST + al((size_t)NE * CAP * 4);
constexpr size_t WS_TINFO = WS_CW   + al((size_t)NE * CAP * 4);
constexpr size_t WS_BAR   = WS_TINFO + al((size_t)L * 16);
constexpr size_t WS_HM    = WS_BAR  + al((size_t)3456 * 4);
constexpr size_t WS_VT    = WS_HM   + (size_t)MT * D * 2;
constexpr size_t WS_POOL  = WS_VT   + (size_t)ATT * MT * 2;
constexpr size_t WS_Q     = WS_POOL + (size_t)L * ATT * 2;
constexpr size_t WS_K     = WS_Q    + (size_t)MT * ATT * 2;
constexpr size_t WS_SA    = WS_K    + (size_t)MT * ATT * 2;
constexpr size_t WS_SB    = WS_SA   + (size_t)L * D * 2;
constexpr size_t WS_END   = WS_SB   + (size_t)L * D * 2;
constexpr size_t WS_YATT  = WS_HM;
constexpr size_t WS_POOLED= WS_HM + (size_t)L * ATT * 2;
constexpr size_t WS_Z     = WS_Q;
constexpr size_t WS_Y     = WS_SA;
constexpr size_t WS_HM2   = WS_HM;
constexpr size_t WS_ACT   = WS_Q;
constexpr size_t WS_OUTP  = WS_HM;
static_assert(WS_HM + (size_t)2 * L * D * 2 <= WS_Q, "outp must fit in HM+VT+POOL");
static_assert((size_t)2 * L * DE * 2 <= (size_t)2 * MT * ATT * 2, "act must fit in Q+K");

struct Params {
    const float *x, *c, *ctx, *c_ctx, *ln_in_g, *ln_in_b, *w_mod, *b_mod, *w_in, *rpb, *w_pool_grp, *pool_scale,
                *w_attn_proj, *w_pool_proj, *w_out, *ln1_g, *ln1_b, *w_rg, *b_rg, *w_re, *b_re, *w_gate, *w_up, *w_down, *ln2_g, *ln2_b;
    float* out;
    unsigned char* ws;
    int ph_lo, ph_hi;
};

DI u16 f2bf(float x) { __bf16 b = (__bf16)x; return __builtin_bit_cast(u16, b); }
DI float bf2f(u16 b) { return __uint_as_float(((unsigned)b) << 16); }
typedef __bf16 bf16x2_t __attribute__((ext_vector_type(2)));
typedef float f32x2_t __attribute__((ext_vector_type(2)));
DI unsigned pack2(float a, float b) { f32x2_t v = {a, b}; bf16x2_t r = __builtin_convertvector(v, bf16x2_t); return __builtin_bit_cast(unsigned, r); }
template <int CTRL> DI float dpp_f(float v) { return __int_as_float(__builtin_amdgcn_update_dpp(0, __float_as_int(v), CTRL, 0xF, 0xF, true)); }
DI float rl(float v, int l) { return __int_as_float(__builtin_amdgcn_readlane(__float_as_int(v), l)); }
DI float row_sum16(float v) {
    v += dpp_f<0xB1>(v); v += dpp_f<0x4E>(v); v += dpp_f<0x141>(v); v += dpp_f<0x140>(v); return v;
}
DI float wave_sum(float v) { v = row_sum16(v); return (rl(v, 0) + rl(v, 16)) + (rl(v, 32) + rl(v, 48)); }
DI float sigmoidf_(float x) { return __builtin_amdgcn_rcpf(1.f + __expf(-x)); }
DI float siluf_(float x) { return x * __builtin_amdgcn_rcpf(1.f + __expf(-x)); }

#define LAS __attribute__((address_space(3)))
typedef float f32x4 __attribute__((ext_vector_type(4)));
typedef unsigned u32x4 __attribute__((ext_vector_type(4)));
typedef unsigned u32x2 __attribute__((ext_vector_type(2)));
namespace pg {
constexpr int BM = 256, BK = 64, HALF = 128, HTB = HALF * BK * 2, STAGE_BYTES = 8 * HTB, NXCD = 8, WGM = 8;
DI int lds_byte(int r, int c) { const int st = (r >> 4) * 2 + (c >> 5), rr = r & 15, cc = c & 31, ob = rr * 64 + cc * 2; return st * 1024 + (ob ^ (((ob >> 9) & 1) << 5)); }
DI void stage_rc(int b, int& R, int& C) { const int st = b / 1024, sb = b % 1024, swz = sb ^ (((sb >> 9) & 1) << 5); R = (st >> 1) * 16 + swz / 64; C = (st & 1) * 32 + (swz % 64) / 2; }
DI int perm32(int rho) { const int n = rho >> 4, i = rho & 15; return 8 * (i >> 2) + 4 * n + (i & 3); }
DI unsigned cvt_pk_bf16(float lo, float hi) { return pack2(lo, hi); }

struct Unit { int pm, pn, e, tl, cnt; const char* A; const char* B; unsigned ao[2][2]; };

struct DenseSched {
    const char* A; const char* Bt; int nM, nN, nwg, G, c, K;
    DI void init(const void* A_, const void* Bt_, int M, int N, int K_) { A = (const char*)A_; Bt = (const char*)Bt_; nM = M / BM; nN = N / BM; nwg = nM * nN; G = gridDim.x; c = blockIdx.x; K = K_; }
    DI bool next(int i, Unit& u, const int (&R)[2], const int (&C)[2]) const {
        const long Lx = (long)i * G + c; if (Lx >= nwg) return false;
        int wgid = (int)Lx; { const int q = nwg / NXCD, r = nwg % NXCD, xcd = wgid % NXCD, off = wgid / NXCD; wgid = (xcd < r ? xcd * (q + 1) : r * (q + 1) + (xcd - r) * q) + off; }
        const int nig = WGM * nN, gid = wgid / nig, fm = gid * WGM, gsz = (nM - fm) < WGM ? (nM - fm) : WGM;
        u.pm = fm + ((wgid % nig) % gsz); u.pn = (wgid % nig) / gsz; u.e = 0; u.tl = u.pm; u.cnt = 0x7fffffff;
        u.A = A; u.B = Bt + (size_t)u.pn * BM * K * 2;
#pragma unroll
        for (int h = 0; h < 2; ++h)
#pragma unroll
            for (int j = 0; j < 2; ++j) u.ao[h][j] = (unsigned)((u.pm * BM + h * HALF + R[j]) * K + C[j]) * 2u;
        return true;
    }
};

template <class Epi, class Sched>
DI void gemm_phase(LAS unsigned char* lds, const int K, const Sched& S, const Epi& E) {
    const int tid = threadIdx.x, wid = __builtin_amdgcn_readfirstlane(tid >> 6), lane = tid & 63, wr = wid >> 2, wc = wid & 3, fr = lane & 15, fq = lane >> 4;
    const int nt = K / BK;
    int sR[2], sC[2]; unsigned voffB[2];
#pragma unroll
    for (int i = 0; i < 2; ++i) { stage_rc(tid * 16 + i * 8192, sR[i], sC[i]); const int Rb = Epi::PERM ? ((sR[i] & ~31) + perm32(sR[i] & 31)) : sR[i];
        voffB[i] = (unsigned)(Rb * K + sC[i]) * 2u; }
    const size_t kstep = (size_t)(BK * 2);
    const size_t hstep = (size_t)HALF * K * 2;
    const unsigned ldsw = (unsigned)wid * 1024u;
    const int aoff = lds_byte(wr * 64 + fr, fq * 8), boff = lds_byte(wc * 32 + fr, fq * 8);
#define PG_SA(b, h) (((b) * 2 + (h)) * HTB)
#define PG_SB(b, h) ((4 + (b) * 2 + (h)) * HTB)
#define PG_STAGE(bufoff, gbase, voff) do { _Pragma("unroll") for (int _i = 0; _i < 2; ++_i) \
        __builtin_amdgcn_global_load_lds((const unsigned*)((const char*)(gbase) + (voff)[_i]), (LAS unsigned*)(lds + (bufoff) + ldsw + _i * 8192), 16, 0, 0); } while (0)
#define PG_LDA(dst, b, h) do { _Pragma("unroll") for (int m = 0; m < 4; ++m) _Pragma("unroll") for (int k = 0; k < 2; ++k) dst[m][k] = *(const LAS bf16x8*)(lds + PG_SA(b, h) + aoff + m * 2048 + k * 1024); } while (0)
#define PG_LDB(dst, b, h) do { _Pragma("unroll") for (int n = 0; n < 2; ++n) _Pragma("unroll") for (int k = 0; k < 2; ++k) dst[n][k] = *(const LAS bf16x8*)(lds + PG_SB(b, h) + boff + n * 2048 + k * 1024); } while (0)
#define PG_MMA(ai, bj, At, Bt) do { __builtin_amdgcn_s_setprio(1); _Pragma("unroll") for (int m = 0; m < 4; ++m) _Pragma("unroll") for (int n = 0; n < 2; ++n) _Pragma("unroll") for (int k = 0; k < 2; ++k) \
        acc[ai][bj][m][n] = __builtin_amdgcn_mfma_f32_16x16x32_bf16(Bt[n][k], At[m][k], acc[ai][bj][m][n], 0, 0, 0); __builtin_amdgcn_s_setprio(0); } while (0)
#define PG_WAIT_V(n) asm volatile("s_waitcnt vmcnt(" #n ")" ::: "memory")
#define PG_WAIT_L(n) asm volatile("s_waitcnt lgkmcnt(" #n ")" ::: "memory")
#define PG_BAR __builtin_amdgcn_s_barrier()
#define PG_SCHED __builtin_amdgcn_sched_barrier(0)
    Unit cur, nxt; int ui = 0;
    if (!S.next(0, cur, sR, sC)) return;
    f32x4 acc[2][2][4][2];
#pragma unroll
    for (int a = 0; a < 2; ++a)
#pragma unroll
        for (int b = 0; b < 2; ++b)
#pragma unroll
            for (int m = 0; m < 4; ++m)
#pragma unroll
                for (int n = 0; n < 2; ++n) acc[a][b][m][n] = (f32x4){0.f, 0.f, 0.f, 0.f};
    bf16x8 At[4][2], B0[2][2], B1[2][2];
    PG_STAGE(PG_SB(0, 0), cur.B, voffB); PG_STAGE(PG_SB(0, 1), cur.B + hstep, voffB); PG_STAGE(PG_SA(0, 0), cur.A, cur.ao[0]); PG_STAGE(PG_SA(0, 1), cur.A, cur.ao[1]);
    if (wr == 1) PG_BAR;
    PG_WAIT_V(2); PG_BAR;
    PG_STAGE(PG_SB(1, 0), cur.B + kstep, voffB); PG_STAGE(PG_SA(1, 0), cur.A + kstep, cur.ao[0]); PG_STAGE(PG_SB(1, 1), cur.B + hstep + kstep, voffB);
    PG_WAIT_V(6); PG_BAR;
    for (;;) {
        const bool has_next = S.next(ui + 1, nxt, sR, sC);
        if (!has_next) nxt = cur;
        for (int t = 0; t < nt; t += 2) {
            const bool last = (t == nt - 2);
            const char* a1 = cur.A + (size_t)(t + 1) * kstep;
            const char* a2 = last ? nxt.A : cur.A + (size_t)(t + 2) * kstep; const char* b2 = last ? nxt.B : cur.B + (size_t)(t + 2) * kstep;
            const char* a3 = a2 + kstep; const char* b3 = b2 + kstep;
            unsigned s0[2], s1[2];
            s0[0] = last ? nxt.ao[0][0] : cur.ao[0][0]; s0[1] = last ? nxt.ao[0][1] : cur.ao[0][1];
            s1[0] = last ? nxt.ao[1][0] : cur.ao[1][0]; s1[1] = last ? nxt.ao[1][1] : cur.ao[1][1];
            PG_LDB(B0, 0, 0); PG_LDB(B1, 0, 1); PG_SCHED; PG_LDA(At, 0, 0); PG_STAGE(PG_SA(1, 1), a1, cur.ao[1]);
            PG_WAIT_V(8); PG_WAIT_L(0); PG_BAR; PG_MMA(0, 0, At, B0); PG_MMA(0, 1, At, B1); PG_BAR; PG_SCHED;
            PG_LDA(At, 0, 1); PG_STAGE(PG_SB(0, 0), b2, voffB); PG_STAGE(PG_SB(0, 1), b2 + hstep, voffB); PG_STAGE(PG_SA(0, 0), a2, s0);
            PG_WAIT_V(8); PG_WAIT_L(0); PG_BAR; PG_MMA(1, 0, At, B0); PG_MMA(1, 1, At, B1); PG_BAR; PG_SCHED;
            PG_LDB(B0, 1, 0); PG_LDB(B1, 1, 1); PG_SCHED; PG_LDA(At, 1, 0); PG_STAGE(PG_SA(0, 1), a2, s1);
            PG_WAIT_V(8); PG_WAIT_L(0); PG_BAR; PG_MMA(0, 0, At, B0); PG_MMA(0, 1, At, B1); PG_BAR; PG_SCHED;
            PG_LDA(At, 1, 1); PG_STAGE(PG_SB(1, 0), b3, voffB); PG_STAGE(PG_SB(1, 1), b3 + hstep, voffB); PG_STAGE(PG_SA(1, 0), a3, s0);
            PG_WAIT_V(8); PG_WAIT_L(0); PG_BAR; PG_MMA(1, 0, At, B0); PG_MMA(1, 1, At, B1); PG_BAR; PG_SCHED;
        }
        if (wr == 0) PG_BAR;
        E(acc, cur, wr, wc, fr, fq);
        if (!has_next) break;
#pragma unroll
        for (int a = 0; a < 2; ++a)
#pragma unroll
            for (int b = 0; b < 2; ++b)
#pragma unroll
                for (int m = 0; m < 4; ++m)
#pragma unroll
                    for (int n = 0; n < 2; ++n) acc[a][b][m][n] = (f32x4){0.f, 0.f, 0.f, 0.f};
        cur = nxt; ++ui;
        if (wr == 1) PG_BAR;
    }
    PG_WAIT_V(0);
    PG_BAR;
#undef PG_SA
#undef PG_SB
#undef PG_STAGE
#undef PG_LDA
#undef PG_LDB
#undef PG_MMA
#undef PG_WAIT_V
#undef PG_WAIT_L
#undef PG_BAR
#undef PG_SCHED
}
}

DI u32x4 pack8v(const f32x4& v0, const f32x4& v1) {
    u32x4 w; w.x = pg::cvt_pk_bf16(v0[0], v0[1]); w.y = pg::cvt_pk_bf16(v0[2], v0[3]); w.z = pg::cvt_pk_bf16(v1[0], v1[1]); w.w = pg::cvt_pk_bf16(v1[2], v1[3]); return w;
}
DI float bflo(unsigned u) { return __uint_as_float(u << 16); }
DI float bfhi(unsigned u) { return __uint_as_float(u & 0xffff0000u); }

struct TpDesc { const float* src; u16* dst; int ld_src, ld_dst, r0, c0, mode; };
constexpr int TP_WIN = 512, TP_WA = 64, TP_WOUT = 128, TP_G = 2048, TP_U = 2048, TP_DN = 2048;
constexpr int TP_TOTAL = TP_WIN + TP_WA + TP_WOUT + TP_G + TP_U + TP_DN;
DI TpDesc tp_decode(const Params& p, int i) {
    TpDesc d;
    if (i < TP_WIN) { d.src = p.w_in; d.ld_src = PROJ; d.dst = (u16*)(p.ws + WS_WIN); d.ld_dst = D; d.r0 = (i / 32) * 64; d.c0 = (i % 32) * 128; d.mode = 0; return d; }
    i -= TP_WIN;
    if (i < TP_WA) { d.src = p.w_attn_proj; d.ld_src = D; d.dst = (u16*)(p.ws + WS_WA); d.ld_dst = ATT; d.r0 = (i / 8) * 64; d.c0 = (i % 8) * 128; d.mode = 0; return d; }
    i -= TP_WA;
    if (i < TP_WOUT) { d.src = p.w_out; d.ld_src = D; d.dst = (u16*)(p.ws + WS_WOUT); d.ld_dst = D; d.r0 = (i / 8) * 64; d.c0 = (i % 8) * 128; d.mode = 0; return d; }
    i -= TP_WOUT;
    if (i < TP_G) { const int e = i >> 6, j = i & 63;
        d.src = p.w_gate + (size_t)e * D * DE; d.ld_src = DE; d.dst = (u16*)(p.ws + WS_WGU) + (size_t)e * 1024 * D; d.ld_dst = D; d.r0 = (j / 4) * 64; d.c0 = (j % 4) * 128; d.mode = 1; return d; }
    i -= TP_G;
    if (i < TP_U) { const int e = i >> 6, j = i & 63;
        d.src = p.w_up + (size_t)e * D * DE; d.ld_src = DE; d.dst = (u16*)(p.ws + WS_WGU) + (size_t)e * 1024 * D; d.ld_dst = D; d.r0 = (j / 4) * 64; d.c0 = (j % 4) * 128; d.mode = 2; return d; }
    i -= TP_U;
    { const int e = i >> 6, j = i & 63;
        d.src = p.w_down + (size_t)e * DE * D; d.ld_src = D; d.dst = (u16*)(p.ws + WS_WDN) + (size_t)e * D * DE; d.ld_dst = DE; d.r0 = (j / 8) * 64; d.c0 = (j % 8) * 128; d.mode = 0; return d; }
}
DI void tp_load(const TpDesc& d, f32x4 (&v)[4]) {
    const int sub = threadIdx.x >> 8, t = threadIdx.x & 255;
#pragma unroll
    for (int i = 0; i < 4; ++i) {
        const int row = (t >> 4) + 16 * i, c4 = (t & 15) * 4;
        v[i] = __builtin_nontemporal_load((const f32x4*)(d.src + (size_t)(d.r0 + row) * d.ld_src + d.c0 + sub * 64 + c4));
    }
}
DI void tp_to_lds(float* lt, const f32x4 (&v)[4]) {
    const int sub = threadIdx.x >> 8, t = threadIdx.x & 255;
    lt += sub * 64 * 65;
#pragma unroll
    for (int i = 0; i < 4; ++i) {
        const int row = (t >> 4) + 16 * i, c4 = (t & 15) * 4;
        lt[row * 65 + c4 + 0] = v[i][0]; lt[row * 65 + c4 + 1] = v[i][1]; lt[row * 65 + c4 + 2] = v[i][2]; lt[row * 65 + c4 + 3] = v[i][3];
    }
}
DI void tp_store(const float* lt, const TpDesc& d) {
    const int sub = threadIdx.x >> 8, t = threadIdx.x & 255;
    lt += sub * 64 * 65;
    const int c = t >> 2, rc = (t & 3) * 16;
    const int cg_ = d.c0 + sub * 64 + c;
    int drow = cg_;
    if (d.mode == 1) drow = (cg_ >> 7) * 256 + (cg_ & 127);
    else if (d.mode == 2) drow = (cg_ >> 7) * 256 + (cg_ & 127) + 128;
    unsigned pk[8];
#pragma unroll
    for (int e = 0; e < 8; ++e) pk[e] = pack2(lt[(rc + 2 * e) * 65 + c], lt[(rc + 2 * e + 1) * 65 + c]);
    uint4* dp = (uint4*)(d.dst + (size_t)drow * d.ld_dst + d.r0 + rc);
    dp[0] = make_uint4(pk[0], pk[1], pk[2], pk[3]);
    dp[1] = make_uint4(pk[4], pk[5], pk[6], pk[7]);
}

DI void phase0(const Params& p, char* lds) {
    float* lt = (float*)lds;
    const int t = threadIdx.x;
    constexpr int I_MOD = 192, I_WPC = 64, I_MISC = 1;
    for (int it = blockIdx.x; it < I_MOD + I_WPC + I_MISC; it += gridDim.x) {
        int i = it;
        if (i < I_MOD) {
            const int cc = i % 12, kc = i / 12;
            const int col = cc * 512 + t;
            float* lsil = (float*)lds;
            __syncthreads();
            if (t < 128) { const int k = kc * 64 + (t & 63); lsil[t] = siluf_((t < 64) ? p.c[k] : p.c_ctx[k]); }
            __syncthreads();
            float a0 = 0.f, a1 = 0.f;
#pragma unroll
            for (int kb = 0; kb < 4; ++kb) {
                float wv[16];
#pragma unroll
                for (int j = 0; j < 16; ++j) wv[j] = __builtin_nontemporal_load(p.w_mod + (size_t)(kc * 64 + kb * 16 + j) * 6144 + col);
#pragma unroll
                for (int j = 0; j < 16; ++j) { a0 += lsil[kb * 16 + j] * wv[j]; a1 += lsil[64 + kb * 16 + j] * wv[j]; }
            }
            if (kc == 0) { const float b = p.b_mod[col]; a0 += b; a1 += b; }
            float* modp = (float*)(p.ws + WS_MODP);
            modp[(kc * 2 + 0) * 6144 + col] = a0;
            modp[(kc * 2 + 1) * 6144 + col] = a1;
            asm volatile("s_waitcnt vmcnt(0)" ::: "memory");
            __syncthreads();
            if (t == 0) {
                __builtin_amdgcn_fence(__ATOMIC_RELEASE, "agent");
                asm volatile("s_waitcnt vmcnt(0)" ::: "memory");
                (void)__hip_atomic_fetch_add((unsigned*)(p.ws + WS_BAR) + 96, 1u, __ATOMIC_RELAXED, __HIP_MEMORY_SCOPE_AGENT);
            }
            continue;
        }
        i -= I_MOD;
        if (i < I_WPC) {
            const int o0 = (i / 4) * 64, g = i % 4;
            float* lw = (float*)lds;
            __syncthreads();
            for (int e = t; e < 128 * 128; e += NTH) lw[e] = p.w_pool_grp[(size_t)g * 16384 + e] * p.pool_scale[g * 128 + (e & 127)];
            __syncthreads();
            const int o = o0 + (t & 63);
            const int iw = (t >> 6) * 16;
            float a[16];
#pragma unroll
            for (int e = 0; e < 16; ++e) a[e] = 0.f;
            for (int jb = 0; jb < 128; jb += 8) {
                float wp[8];
#pragma unroll
                for (int q = 0; q < 8; ++q) wp[q] = p.w_pool_proj[(size_t)(g * 128 + jb + q) * D + o];
#pragma unroll
                for (int e = 0; e < 16; ++e) {
                    const float4 l0 = *(const float4*)(lw + (iw + e) * 128 + jb), l1 = *(const float4*)(lw + (iw + e) * 128 + jb + 4);
                    a[e] += l0.x * wp[0] + l0.y * wp[1] + l0.z * wp[2] + l0.w * wp[3] + l1.x * wp[4] + l1.y * wp[5] + l1.z * wp[6] + l1.w * wp[7];
                }
            }
            unsigned pk[8];
#pragma unroll
            for (int e = 0; e < 8; ++e) pk[e] = pack2(a[2 * e], a[2 * e + 1]);
            uint4* dp = (uint4*)((u16*)(p.ws + WS_WPC) + (size_t)o * ATT + g * 128 + iw);
            dp[0] = make_uint4(pk[0], pk[1], pk[2], pk[3]);
            dp[1] = make_uint4(pk[4], pk[5], pk[6], pk[7]);
            continue;
        }
        {
            float* wrt = (float*)(p.ws + WS_WRT);
#pragma unroll
            for (int kk = 0; kk < 2; ++kk) {
                const int k = t + kk * NTH;
                const float4 rg = *(const float4*)(p.w_rg + (size_t)k * 4);
                float4 re[8];
#pragma unroll
                for (int q = 0; q < 8; ++q) re[q] = *(const float4*)(p.w_re + (size_t)k * 32 + q * 4);
                wrt[0 * 1024 + k] = rg.x; wrt[1 * 1024 + k] = rg.y; wrt[2 * 1024 + k] = rg.z; wrt[3 * 1024 + k] = rg.w;
#pragma unroll
                for (int q = 0; q < 8; ++q) {
                    wrt[(4 + q * 4 + 0) * 1024 + k] = re[q].x; wrt[(4 + q * 4 + 1) * 1024 + k] = re[q].y;
                    wrt[(4 + q * 4 + 2) * 1024 + k] = re[q].z; wrt[(4 + q * 4 + 3) * 1024 + k] = re[q].w;
                }
            }
            if (t < 33) ((int*)(p.ws + WS_CNT))[t * 64] = 0;
        }
    }
    __syncthreads();
    {
        constexpr int TP_P0 = TP_TOTAL - TP_DN;
        unsigned* qhead = (unsigned*)(p.ws + WS_BAR) + 64;
        int* lq = (int*)(lds + 4 * 64 * 65 * 4);
        float* lt0 = lt; float* lt1 = lt + 2 * 64 * 65;
        __syncthreads();
        if (t == 0) lq[0] = (int)atomicAdd(qhead, 2u);
        __syncthreads();
        int ia = lq[0];
        if (ia < TP_P0) {
            TpDesc da = tp_decode(p, ia), db = tp_decode(p, ia + 1);
            f32x4 ra[4], rb[4];
            tp_load(da, ra); tp_load(db, rb);
            for (;;) {
                __syncthreads();
                if (t == 0) lq[0] = (int)atomicAdd(qhead, 2u);
                tp_to_lds(lt0, ra); tp_to_lds(lt1, rb);
                __syncthreads();
                const TpDesc ca = da, cb = db;
                const int na = lq[0];
                const bool more = na < TP_P0;
                da = tp_decode(p, more ? na : ia); db = tp_decode(p, more ? na + 1 : ia);
                tp_load(da, ra); tp_load(db, rb);
                tp_store(lt0, ca); tp_store(lt1, cb);
                if (!more) break;
                ia = na;
            }
        }
        __syncthreads();
    }
}

DI void load_modvec(float* dst, const Params& p, int cond, int vec) {
    const float* modp = (const float*)(p.ws + WS_MODP);
    for (int i = threadIdx.x; i < 1024; i += NTH) {
        float s = 0.f;
#pragma unroll
        for (int kc = 0; kc < 16; ++kc) s += modp[(kc * 2 + cond) * 6144 + vec * 1024 + i];
        dst[i] = s;
    }
}

template <int NB>
DI void ln_rows(float4 (&v)[NB][4], const float* g, const float* b, int lane) {
    float mu[NB], rstd[NB];
#pragma unroll
    for (int r = 0; r < NB; ++r) {
        float s = 0.f;
#pragma unroll
        for (int j = 0; j < 4; ++j) s += v[r][j].x + v[r][j].y + v[r][j].z + v[r][j].w;
        mu[r] = s;
    }
#pragma unroll
    for (int r = 0; r < NB; ++r) mu[r] = wave_sum(mu[r]) * (1.f / 1024.f);
#pragma unroll
    for (int r = 0; r < NB; ++r) {
        float q = 0.f;
#pragma unroll
        for (int j = 0; j < 4; ++j) {
            v[r][j].x -= mu[r]; v[r][j].y -= mu[r]; v[r][j].z -= mu[r]; v[r][j].w -= mu[r];
            q += v[r][j].x * v[r][j].x + v[r][j].y * v[r][j].y + v[r][j].z * v[r][j].z + v[r][j].w * v[r][j].w;
        }
        rstd[r] = q;
    }
#pragma unroll
    for (int r = 0; r < NB; ++r) rstd[r] = rsqrtf(wave_sum(rstd[r]) * (1.f / 1024.f) + LN_EPS);
#pragma unroll
    for (int j = 0; j < 4; ++j) {
        const float4 gg = *(const float4*)(g + (j * 64 + lane) * 4);
        const float4 bb = *(const float4*)(b + (j * 64 + lane) * 4);
#pragma unroll
        for (int r = 0; r < NB; ++r) {
            v[r][j].x = v[r][j].x * rstd[r] * gg.x + bb.x; v[r][j].y = v[r][j].y * rstd[r] * gg.y + bb.y;
            v[r][j].z = v[r][j].z * rstd[r] * gg.z + bb.z; v[r][j].w = v[r][j].w * rstd[r] * gg.w + bb.w;
        }
    }
}

DI void phase1(const Params& p, char* lds) {
    if (threadIdx.x == 0) {
        unsigned* mc = (unsigned*)(p.ws + WS_BAR) + 96;
        unsigned sp = 0;
        while (__hip_atomic_load(mc, __ATOMIC_RELAXED, __HIP_MEMORY_SCOPE_AGENT) < 192u) { __builtin_amdgcn_s_sleep(1); if (++sp > (1u << 22)) break; }
        __builtin_amdgcn_fence(__ATOMIC_ACQUIRE, "agent");
        asm volatile("s_waitcnt vmcnt(0)" ::: "memory");
    }
    __syncthreads();
    float* lm = (float*)lds;
    load_modvec(lm + 0, p, 0, 0); load_modvec(lm + 1024, p, 0, 1);
    load_modvec(lm + 2048, p, 1, 0); load_modvec(lm + 3072, p, 1, 1);
    __syncthreads();
    const int lane = threadIdx.x & 63, w = threadIdx.x >> 6;
    u16* hm = (u16*)(p.ws + WS_HM);
    for (int row0 = (blockIdx.x * NWV + w) * 4; row0 < MT; row0 += gridDim.x * NWV * 4) {
        const float* src = (row0 < L) ? (p.x + (size_t)row0 * D) : (p.ctx + (size_t)(row0 - L) * D);
        const float* sh = lm + ((row0 < L) ? 0 : 2048);
        const float* sc = sh + 1024;
        float4 v[4][4];
#pragma unroll
        for (int r = 0; r < 4; ++r)
#pragma unroll
            for (int j = 0; j < 4; ++j) { const f32x4 xv = __builtin_nontemporal_load((const f32x4*)(src + (size_t)r * D + (j * 64 + lane) * 4)); v[r][j] = make_float4(xv[0], xv[1], xv[2], xv[3]); }
        ln_rows<4>(v, p.ln_in_g, p.ln_in_b, lane);
#pragma unroll
        for (int j = 0; j < 4; ++j) {
            const int e = (j * 64 + lane) * 4;
            const float4 s4 = *(const float4*)(sh + e), c4 = *(const float4*)(sc + e);
#pragma unroll
            for (int r = 0; r < 4; ++r) {
                const float m0 = v[r][j].x * (1.f + c4.x) + s4.x, m1 = v[r][j].y * (1.f + c4.y) + s4.y;
                const float m2 = v[r][j].z * (1.f + c4.z) + s4.z, m3 = v[r][j].w * (1.f + c4.w) + s4.w;
                *(uint2*)(hm + (size_t)(row0 + r) * D + e) = make_uint2(pack2(m0, m1), pack2(m2, m3));
            }
        }
    }
}

struct EpiP2 {
    static constexpr bool PERM = true;
    unsigned char* ws;
    DI void operator()(const f32x4 (&acc)[2][2][4][2], const pg::Unit& u, int wr, int wc, int fr, int fq) const {
        const int row0 = u.pm * 256 + wr * 64 + fr;
        const int cu = u.pn * 256;
        const int cl = wc * 32 + 8 * fq;
        if (cu >= 1024 && cu < 1536) {
            u16* VT = (u16*)(ws + WS_VT);
#pragma unroll
            for (int ai = 0; ai < 2; ++ai)
#pragma unroll
                for (int m = 0; m < 4; ++m)
#pragma unroll
                    for (int bj = 0; bj < 2; ++bj) {
                        u16* vp = VT + (size_t)(cu - 1024 + bj * 128 + cl) * MT + row0 + ai * 128 + m * 16;
                        const f32x4 v0 = acc[ai][bj][m][0], v1 = acc[ai][bj][m][1];
#pragma unroll
                        for (int j = 0; j < 4; ++j) { vp[(size_t)j * MT] = f2bf(v0[j]); vp[(size_t)(4 + j) * MT] = f2bf(v1[j]); }
                    }
            return;
        }
        u16* base; int ld; float sc = 1.f;
        if (cu < 512) { base = (u16*)(ws + WS_Q) + cu; ld = ATT; sc = 0.125f * 1.44269504089f; }
        else if (cu < 1024) { base = (u16*)(ws + WS_K) + (cu - 512); ld = ATT; }
        else if (cu < 2048) { base = (u16*)(ws + WS_POOL) + (cu - 1536); ld = ATT; }
        else if (cu < 3072) { base = (u16*)(ws + WS_SA) + (cu - 2048); ld = D; }
        else { base = (u16*)(ws + WS_SB) + (cu - 3072); ld = D; }
        base += (size_t)row0 * ld + cl;
        if (cu < 2048) {
#pragma unroll
            for (int ai = 0; ai < 2; ++ai)
#pragma unroll
                for (int m = 0; m < 4; ++m)
#pragma unroll
                    for (int bj = 0; bj < 2; ++bj)
                        *(u32x4*)(base + (size_t)(ai * 128 + m * 16) * ld + bj * 128) = pack8v(acc[ai][bj][m][0] * sc, acc[ai][bj][m][1] * sc);
        } else {
#pragma unroll
            for (int ai = 0; ai < 2; ++ai)
#pragma unroll
                for (int m = 0; m < 4; ++m)
#pragma unroll
                    for (int bj = 0; bj < 2; ++bj) {
                        f32x4 v0 = acc[ai][bj][m][0], v1 = acc[ai][bj][m][1];
#pragma unroll
                        for (int j = 0; j < 4; ++j) { v0[j] = sigmoidf_(v0[j]); v1[j] = sigmoidf_(v1[j]); }
                        __builtin_nontemporal_store(pack8v(v0, v1), (u32x4*)(base + (size_t)(ai * 128 + m * 16) * D + bj * 128));
                    }
        }
    }
};

DI void ctx_kv_item(const Params& p, int item, char* lds) {
    const int t = threadIdx.x, lane = t & 63, w = t >> 6, lr = lane & 31, lh = lane >> 5;
    const int rb = item >> 5, cb = item & 31;
    const u16* hm = (const u16*)(p.ws + WS_HM); const u16* wt = (const u16*)(p.ws + WS_WIN);
    const u16* ap = hm + (size_t)(L + rb * 32 + lr) * D + w * 128 + 8 * lh;
    const u16* bp = wt + (size_t)(512 + cb * 32 + lr) * D + w * 128 + 8 * lh;
    f32x16 acc;
#pragma unroll
    for (int i = 0; i < 16; ++i) acc[i] = 0.f;
#pragma unroll
    for (int ks = 0; ks < 8; ++ks) {
        const bf16x8 a = *(const bf16x8*)(ap + ks * 16), b = *(const bf16x8*)(bp + ks * 16);
        acc = MFMA(a, b, acc);
    }
    float* part = (float*)lds;
    __syncthreads();
#pragma unroll
    for (int i = 0; i < 16; ++i) part[(w * 32 + (i & 3) + 8 * (i >> 2) + 4 * lh) * 33 + lr] = acc[i];
    __syncthreads();
    const int row = t >> 4, c = (t & 15) * 2;
    float s0 = 0.f, s1 = 0.f;
#pragma unroll
    for (int ww = 0; ww < 8; ++ww) { s0 += part[(ww * 32 + row) * 33 + c]; s1 += part[(ww * 32 + row) * 33 + c + 1]; }
    const int grow = L + rb * 32 + row;
    if (cb < 16) {
        *(unsigned*)((u16*)(p.ws + WS_K) + (size_t)grow * ATT + cb * 32 + c) = pack2(s0, s1);
    } else {
        u16* VT = (u16*)(p.ws + WS_VT);
        VT[(size_t)((cb - 16) * 32 + c) * MT + grow] = f2bf(s0);
        VT[(size_t)((cb - 16) * 32 + c + 1) * MT + grow] = f2bf(s1);
    }
}

DI void phase2(const Params& p, char* lds) {
    pg::DenseSched S; S.init(p.ws + WS_HM, p.ws + WS_WIN, L, PROJ, D);
    EpiP2 E{p.ws};
    pg::gemm_phase(( LAS unsigned char*)lds, D, S, E);
    for (int it = blockIdx.x; it < 256; it += gridDim.x) ctx_kv_item(p, it, lds);
}

DI bf16x8 pack8(float a0, float a1, float a2, float a3, float a4, float a5, float a6, float a7) {
    uint4 u = make_uint4(pack2(a0, a1), pack2(a2, a3), pack2(a4, a5), pack2(a6, a7));
    return __builtin_bit_cast(bf16x8, u);
}

constexpr int LROW = 144;
constexpr int VROW = 272;
constexpr int ATT_LK = 0, ATT_LV = 4 * 128 * LROW, ATT_LB = ATT_LV + 4 * 64 * VROW;

DI void attn_item_rh(int item, int& r, int& hq) {
    if (gridDim.x == 256) { const int c = item & 255; hq = item >> 8; r = 32 * (c & 7) + (c >> 3); }
    else { r = item >> 1; hq = item & 1; }
}
DI void attn_load(const Params& p, int item, int st, u32x4 (&rk)[8], u32x4 (&rv)[8]) {
    const int t = threadIdx.x;
    int r, hq; attn_item_rh(item, r, hq);
    const int rs = min(max(r - 4, 0), 256 - 8);
    const int tokbase = (st < 2) ? (L + st * 128) : ((rs + 2 * (st - 2)) * 64);
    const u16* Kb = (const u16*)(p.ws + WS_K); const u16* VT = (const u16*)(p.ws + WS_VT);
#pragma unroll
    for (int i = 0; i < 8; ++i) {
        const int c = t + NTH * i, hh = c >> 10, key = (c >> 3) & 127, ch = c & 7;
        rk[i] = *(const u32x4*)(Kb + (size_t)(tokbase + key) * ATT + (hq * 4 + hh) * 64 + ch * 8);
    }
#pragma unroll
    for (int i = 0; i < 8; ++i) {
        const int c = t + NTH * i, hh = c >> 10, d = (c >> 4) & 63, ch = c & 15;
        rv[i] = *(const u32x4*)(VT + (size_t)((hq * 4 + hh) * 64 + d) * MT + tokbase + ch * 8);
    }
}
DI void attn_store_lds(char* lds, const u32x4 (&rk)[8], const u32x4 (&rv)[8]) {
    const int t = threadIdx.x;
    char* lk = lds + ATT_LK; char* lv = lds + ATT_LV;
#pragma unroll
    for (int i = 0; i < 8; ++i) {
        const int c = t + NTH * i, hh = c >> 10, key = (c >> 3) & 127, ch = c & 7;
        *(u32x4*)(lk + (hh * 128 + key) * LROW + ch * 16) = rk[i];
    }
#pragma unroll
    for (int i = 0; i < 8; ++i) {
        const int c = t + NTH * i, hh = c >> 10, d = (c >> 4) & 63, ch = c & 15;
        char* rowp = lv + (hh * 64 + d) * VROW;
        *(uint2*)(rowp + (16 * (ch >> 1) + 4 * (ch & 1)) * 2) = make_uint2(rv[i].x, rv[i].y);
        *(uint2*)(rowp + (16 * (ch >> 1) + 8 + 4 * (ch & 1)) * 2) = make_uint2(rv[i].z, rv[i].w);
    }
}

template <int KIND>
DI void attn_sub(const char* lkrow, const char* lvrow, int vpos0, int vpos1, const float* btA, const float* btB, int kA, int kB,
                 int qc, int cs, int lh, const bf16x8 (&qf)[4], f32x16& o0, f32x16& o1, float& m, float& lsum) {
    f32x16 s;
#pragma unroll
    for (int i = 0; i < 16; ++i) s[i] = 0.f;
#pragma unroll
    for (int ks = 0; ks < 4; ++ks) {
        const bf16x8 kf = *(const bf16x8*)(lkrow + (ks * 2 + lh) * 16);
        s = MFMA(kf, qf[ks], s);
    }
    if (KIND == 1) {
        const float* pA = btA + (kA + 4 * lh - qc + 15);
        const float* pB = btB + (kB + 4 * lh - qc + 15);
        const int wA = kA + 4 * lh - cs, wB = kB + 4 * lh - cs;
        float bv[16];
#pragma unroll
        for (int i = 0; i < 16; ++i) bv[i] = ((i < 8) ? pA : pB)[(i & 3) + 8 * (i >> 2)];
#pragma unroll
        for (int i = 0; i < 16; ++i) {
            const bool valid = (unsigned)(((i < 8) ? wA : wB) + (i & 3) + 8 * (i >> 2)) < 16u;
            s[i] = valid ? (s[i] + bv[i]) : -1e30f;
        }
    }
    float tmax = s[0];
#pragma unroll
    for (int i = 1; i < 16; ++i) tmax = fmaxf(tmax, s[i]);
    if (!__all(tmax - m <= 8.f)) {
        tmax = fmaxf(tmax, __shfl_xor(tmax, 32));
        const float mnew = fmaxf(m, tmax);
        const float alpha = __builtin_amdgcn_exp2f(m - mnew);
        lsum *= alpha;
        m = mnew;
#pragma unroll
        for (int i = 0; i < 16; ++i) { o0[i] *= alpha; o1[i] *= alpha; }
    }
    float psum = 0.f;
#pragma unroll
    for (int i = 0; i < 16; ++i) { s[i] = __builtin_amdgcn_exp2f(s[i] - m); psum += s[i]; }
    lsum += psum;
#pragma unroll
    for (int j = 0; j < 2; ++j) {
        const bf16x8 pf = pack8(s[8 * j + 0], s[8 * j + 1], s[8 * j + 2], s[8 * j + 3], s[8 * j + 4], s[8 * j + 5], s[8 * j + 6], s[8 * j + 7]);
        const int vp = j ? vpos1 : vpos0;
        const bf16x8 v0 = *(const bf16x8*)(lvrow + (vp + 8 * lh) * 2);
        const bf16x8 v1 = *(const bf16x8*)(lvrow + 32 * VROW + (vp + 8 * lh) * 2);
        o0 = MFMA(v0, pf, o0);
        o1 = MFMA(v1, pf, o1);
    }
}

DI void attn_phase(const Params& p, char* lds) {
    const int t = threadIdx.x, lane = t & 63, w = t >> 6;
    const int hl = w >> 1, qh = w & 1;
    const int lr = lane & 31, lh = lane >> 5;
    const int qc = qh * 32 + lr;
    const int cs = min(max(qc - 8, 0), 48);
    const u16* Q = (const u16*)(p.ws + WS_Q);
    u16* YA = (u16*)(p.ws + WS_YATT);
    const char* lk = lds + ATT_LK; const char* lv = lds + ATT_LV; float* lbias = (float*)(lds + ATT_LB);
    constexpr int N_ATT = 512;
    int item = blockIdx.x;
    if (item >= N_ATT) return;
    u32x4 rk[8], rv[8];
    attn_load(p, item, 0, rk, rv);
    bf16x8 qf[4];
    f32x16 o0, o1;
    float m = -1e30f, lsum = 0.f;
    int st = 0;
    for (;;) {
        int r, hq; attn_item_rh(item, r, hq);
        const int head = hq * 4 + hl, tok = r * 64 + qc;
        const int rs = min(max(r - 4, 0), 256 - 8);
        __syncthreads();
        attn_store_lds(lds, rk, rv);
        if (st == 0) {
            for (int i = t; i < 4 * 465; i += NTH) lbias[i] = p.rpb[hq * 4 * 465 + i] * 1.44269504089f;
#pragma unroll
            for (int ks = 0; ks < 4; ++ks) qf[ks] = *(const bf16x8*)(Q + (size_t)tok * ATT + head * 64 + ks * 16 + lh * 8);
#pragma unroll
            for (int i = 0; i < 16; ++i) { o0[i] = 0.f; o1[i] = 0.f; }
            m = -1e30f; lsum = 0.f;
        }
        __syncthreads();
        int nitem = item, nst = st + 1;
        if (nst == 6) { nst = 0; nitem = item + gridDim.x; }
        const bool more = nitem < N_ATT;
        attn_load(p, more ? nitem : item, more ? nst : st, rk, rv);
        {
            const char* lkh = lk + hl * 128 * LROW;
            const char* lvrow = lv + (hl * 64 + lr) * VROW;
            if (st < 2) {
#pragma unroll 1
                for (int sub = 0; sub < 4; ++sub)
                    attn_sub<0>(lkh + (sub * 32 + lr) * LROW, lvrow, sub * 32, sub * 32 + 16, lbias, lbias, 0, 0, qc, cs, lh, qf, o0, o1, m, lsum);
            } else {
                const int g0 = rs + 2 * (st - 2);
                const float* bt0 = lbias + hl * 465 + (g0 - r + 7) * 31;
                const float* bt1 = bt0 + 31;
                const int fb = qh * 32;
                const int cb = qh ? 16 : 32;
                attn_sub<1>(lkh + (fb + lr) * LROW, lvrow, fb, fb + 16, bt0, bt0, fb, fb, qc, cs, lh, qf, o0, o1, m, lsum);
                attn_sub<1>(lkh + (64 + fb + lr) * LROW, lvrow, 64 + fb, 64 + fb + 16, bt1, bt1, fb, fb, qc, cs, lh, qf, o0, o1, m, lsum);
                attn_sub<1>(lkh + (((lr < 16) ? cb : 48 + cb) + lr) * LROW, lvrow, cb, 64 + cb, bt0, bt1, cb, cb - 16, qc, cs, lh, qf, o0, o1, m, lsum);
            }
        }
        if (st == 5) {
            const float inv = 1.f / (lsum + __shfl_xor(lsum, 32));
            u16* rowp = YA + (size_t)tok * ATT + head * 64 + (lh ? 8 : 0);
#pragma unroll
            for (int dt = 0; dt < 2; ++dt)
#pragma unroll
                for (int q = 0; q < 4; q += 2) {
                    unsigned ax, ay, bx, by;
                    if (dt == 0) { ax = pack2(o0[q * 4] * inv, o0[q * 4 + 1] * inv); ay = pack2(o0[q * 4 + 2] * inv, o0[q * 4 + 3] * inv);
                                   bx = pack2(o0[q * 4 + 4] * inv, o0[q * 4 + 5] * inv); by = pack2(o0[q * 4 + 6] * inv, o0[q * 4 + 7] * inv); }
                    else         { ax = pack2(o1[q * 4] * inv, o1[q * 4 + 1] * inv); ay = pack2(o1[q * 4 + 2] * inv, o1[q * 4 + 3] * inv);
                                   bx = pack2(o1[q * 4 + 4] * inv, o1[q * 4 + 5] * inv); by = pack2(o1[q * 4 + 6] * inv, o1[q * 4 + 7] * inv); }
                    const auto rx = __builtin_amdgcn_permlane32_swap(ax, bx, false, false);
                    const auto ry = __builtin_amdgcn_permlane32_swap(ay, by, false, false);
                    const u32x4 w = {rx[0], ry[0], rx[1], ry[1]};
                    *(u32x4*)(rowp + dt * 32 + q * 8) = w;
                }
        }
        if (!more) break;
        item = nitem; st = nst;
    }
    __syncthreads();
}

DI void pool_item(const Params& p, int pt, char* lds) {
    const int tok0 = pt * 64;
    const u16* PLb = (const u16*)(p.ws + WS_POOL);
    __syncthreads();
    for (int c = threadIdx.x; c < 80 * 64; c += NTH) {
        const int row = c >> 6, ch = c & 63, tt = tok0 - 8 + row;
        u32x4 v = (u32x4){0u, 0u, 0u, 0u};
        if (tt >= 0 && tt < L) v = *(const u32x4*)(PLb + (size_t)tt * ATT + ch * 8);
        *(u32x4*)(lds + row * 1024 + ch * 16) = v;
    }
    __syncthreads();
    const int t = threadIdx.x & 255, th = threadIdx.x >> 8;
    const unsigned* lp = (const unsigned*)lds;
    unsigned* PD = (unsigned*)(p.ws + WS_POOLED);
    const int g = t >> 6;
    const int half = 1 << g;
    const int tl0 = th * 32;
    float s0 = 0.f, s1 = 0.f;
    for (int k = -half; k < half; ++k) { const unsigned u = lp[(tl0 + k + 8) * 256 + t]; s0 += bflo(u); s1 += bfhi(u); }
#pragma unroll 8
    for (int i = 0; i < 32; ++i) {
        const int tl = tl0 + i, tok = tok0 + tl;
        const int lo = max(tok - half, 0), hi = min(tok + half, L);
        const float invn = 1.f / (float)(hi - lo);
        const unsigned u = lp[(tl + 8) * 256 + t];
        PD[(size_t)tok * 256 + t] = pack2(s0 * invn - bflo(u), s1 * invn - bfhi(u));
        const unsigned ua = lp[(tl + half + 8) * 256 + t], ud = lp[(tl - half + 8) * 256 + t];
        s0 += bflo(ua) - bflo(ud); s1 += bfhi(ua) - bfhi(ud);
    }
}

DI void phase3(const Params& p, char* lds) {
    attn_phase(p, lds);
    for (int it = blockIdx.x; it < 256; it += gridDim.x) pool_item(p, it, lds);
}

template <int PASS> struct EpiP4 {
    static constexpr bool PERM = true;
    unsigned char* ws;
    DI void operator()(const f32x4 (&acc)[2][2][4][2], const pg::Unit& u, int wr, int wc, int fr, int fq) const {
        const u16* G = (const u16*)(ws + (PASS == 0 ? WS_SA : WS_SB));
        u16* Z = (u16*)(ws + WS_Z);
        const int row0 = u.pm * 256 + wr * 64 + fr;
#pragma unroll
        for (int ai = 0; ai < 2; ++ai)
#pragma unroll
            for (int m = 0; m < 4; ++m)
#pragma unroll
                for (int bj = 0; bj < 2; ++bj) {
                    const size_t o = (size_t)(row0 + ai * 128 + m * 16) * D + u.pn * 256 + bj * 128 + wc * 32 + 8 * fq;
                    const u32x4 g = __builtin_nontemporal_load((const u32x4*)(G + o));
                    f32x4 v0 = acc[ai][bj][m][0], v1 = acc[ai][bj][m][1];
                    v0[0] *= bflo(g.x); v0[1] *= bfhi(g.x); v0[2] *= bflo(g.y); v0[3] *= bfhi(g.y);
                    v1[0] *= bflo(g.z); v1[1] *= bfhi(g.z); v1[2] *= bflo(g.w); v1[3] *= bfhi(g.w);
                    if (PASS == 1) {
                        const u32x4 z = *(const u32x4*)(Z + o);
                        v0[0] += bflo(z.x); v0[1] += bfhi(z.x); v0[2] += bflo(z.y); v0[3] += bfhi(z.y);
                        v1[0] += bflo(z.z); v1[1] += bfhi(z.z); v1[2] += bflo(z.w); v1[3] += bfhi(z.w);
                    }
                    *(u32x4*)(Z + o) = pack8v(v0, v1);
                }
    }
};

DI void phase4(const Params& p, char* lds) {
    { pg::DenseSched S; S.init(p.ws + WS_YATT, p.ws + WS_WA, L, D, ATT); EpiP4<0> E{p.ws}; pg::gemm_phase((LAS unsigned char*)lds, ATT, S, E); }
    { pg::DenseSched S; S.init(p.ws + WS_POOLED, p.ws + WS_WPC, L, D, ATT); EpiP4<1> E{p.ws}; pg::gemm_phase((LAS unsigned char*)lds, ATT, S, E); }
}

struct EpiP5 {
    static constexpr bool PERM = true;
    DI bool keep(const pg::Unit&) const { return false; }
    u16* Y;
    DI void operator()(f32x4 (&acc)[2][2][4][2], const pg::Unit& u, int wr, int wc, int fr, int fq) const {
        const int row0 = u.pm * 256 + wr * 64 + fr, col0 = u.pn * 256 + wc * 32 + 8 * fq;
#pragma unroll
        for (int ai = 0; ai < 2; ++ai)
#pragma unroll
            for (int m = 0; m < 4; ++m) {
                u16* rowp = Y + (size_t)(row0 + ai * 128 + m * 16) * D + col0;
#pragma unroll
                for (int bj = 0; bj < 2; ++bj) *(u32x4*)(rowp + bj * 128) = pack8v(acc[ai][bj][m][0], acc[ai][bj][m][1]);
            }
    }
};

DI void phase5(const Params& p, char* lds) {
    pg::DenseSched S; S.init(p.ws + WS_Z, p.ws + WS_WOUT, L, D, D);
    EpiP5 E{(u16*)(p.ws + WS_HM2)};
    pg::gemm_phase((LAS unsigned char*)lds, D, S, E);
}

DI void phase6(const Params& p, char* lds) {
    float* lm = (float*)lds;
    load_modvec(lm, p, 0, 2); load_modvec(lm + 1024, p, 0, 3); load_modvec(lm + 2048, p, 0, 4);
    __syncthreads();
    const int lane = threadIdx.x & 63, w = threadIdx.x >> 6;
    float* Y = (float*)(p.ws + WS_Y);
    u16* HM2 = (u16*)(p.ws + WS_HM2);
    const float* wrt = (const float*)(p.ws + WS_WRT);
    int* cnt = (int*)(p.ws + WS_CNT); int* list = (int*)(p.ws + WS_LIST); float* cw = (float*)(p.ws + WS_CW);
    int4* tinfo = (int4*)(p.ws + WS_TINFO);
    int* lcnt = (int*)(lds + 12288); int* lbase = lcnt + 32; int* recE = lbase + 32; int* recP = recE + 128; float* recC = (float*)(recP + 128);
    float* lwre = (float*)(lds + 16384);
    for (int i = threadIdx.x; i < 32 * 256; i += NTH) *(float4*)(lwre + i * 4) = *(const float4*)(wrt + 4 * 1024 + i * 4);
    for (int tb = blockIdx.x; tb < L / 64; tb += gridDim.x) {
    __syncthreads();
    if (threadIdx.x < 32) lcnt[threadIdx.x] = 0;
    __syncthreads();
    for (int tp = 0; tp < 4; ++tp) {
        constexpr int NB = 2;
        const int tl0 = w * 8 + tp * NB, row0 = tb * 64 + tl0;
        float4 v[NB][4], y[NB][4];
#pragma unroll
        for (int r = 0; r < NB; ++r)
#pragma unroll
            for (int j = 0; j < 4; ++j) {
                { const f32x4 xv = __builtin_nontemporal_load((const f32x4*)(p.x + (size_t)(row0 + r) * D + (j * 64 + lane) * 4)); v[r][j] = make_float4(xv[0], xv[1], xv[2], xv[3]); }
                { const u32x2 ybv = __builtin_nontemporal_load((const u32x2*)(HM2 + (size_t)(row0 + r) * D + (j * 64 + lane) * 4)); const uint2 yb = make_uint2(ybv[0], ybv[1]);
                  y[r][j] = make_float4(bflo(yb.x), bfhi(yb.x), bflo(yb.y), bfhi(yb.y)); }
            }
        ln_rows<NB>(v, p.ln_in_g, p.ln_in_b, lane);
#pragma unroll
        for (int j = 0; j < 4; ++j) {
            const float4 g1 = *(const float4*)(lm + (j * 64 + lane) * 4);
#pragma unroll
            for (int r = 0; r < NB; ++r) {
                v[r][j].x = ALPHA * v[r][j].x + g1.x * y[r][j].x; v[r][j].y = ALPHA * v[r][j].y + g1.y * y[r][j].y;
                v[r][j].z = ALPHA * v[r][j].z + g1.z * y[r][j].z; v[r][j].w = ALPHA * v[r][j].w + g1.w * y[r][j].w;
            }
        }
        ln_rows<NB>(v, p.ln1_g, p.ln1_b, lane);
#pragma unroll
        for (int j = 0; j < 4; ++j) {
            const int e = (j * 64 + lane) * 4;
            const float4 s4 = *(const float4*)(lm + 1024 + e), c4 = *(const float4*)(lm + 2048 + e);
#pragma unroll
            for (int r = 0; r < NB; ++r) {
                { const f32x4 hv = {v[r][j].x, v[r][j].y, v[r][j].z, v[r][j].w}; __builtin_nontemporal_store(hv, (f32x4*)(Y + (size_t)(row0 + r) * D + e)); }
                v[r][j].x = v[r][j].x * (1.f + c4.x) + s4.x; v[r][j].y = v[r][j].y * (1.f + c4.y) + s4.y;
                v[r][j].z = v[r][j].z * (1.f + c4.z) + s4.z; v[r][j].w = v[r][j].w * (1.f + c4.w) + s4.w;
                *(uint2*)(HM2 + (size_t)(row0 + r) * D + e) = make_uint2(pack2(v[r][j].x, v[r][j].y), pack2(v[r][j].z, v[r][j].w));
            }
        }
        const bool h5 = lane & 32, h4 = lane & 16, h3 = lane & 8;
        float cg[NB];
#pragma unroll
        for (int r = 0; r < NB; ++r) {
            float sp[4];
#pragma unroll
            for (int g = 0; g < 4; ++g) sp[g] = 0.f;
#pragma unroll
            for (int j = 0; j < 4; ++j)
#pragma unroll
                for (int g = 0; g < 4; ++g) {
                    const float4 wv = *(const float4*)(wrt + g * 1024 + (j * 64 + lane) * 4);
                    sp[g] += v[r][j].x * wv.x + v[r][j].y * wv.y + v[r][j].z * wv.z + v[r][j].w * wv.w;
                }
            const float a0 = (h5 ? sp[2] : sp[0]) + __shfl_xor(h5 ? sp[0] : sp[2], 32);
            const float a1 = (h5 ? sp[3] : sp[1]) + __shfl_xor(h5 ? sp[1] : sp[3], 32);
            cg[r] = (h4 ? a1 : a0) + __shfl_xor(h4 ? a0 : a1, 16);
        }
        int gsel[NB]; float pg[NB];
#pragma unroll
        for (int r = 0; r < NB; ++r) {
            const float c = row_sum16(cg[r]);
            float lg[4];
#pragma unroll
            for (int g = 0; g < 4; ++g) lg[g] = rl(c, 16 * g) + p.b_rg[g];
            int gs = 0; float gmax = lg[0];
#pragma unroll
            for (int g = 1; g < 4; ++g) if (lg[g] > gmax) { gmax = lg[g]; gs = g; }
            float gden = 0.f;
#pragma unroll
            for (int g = 0; g < 4; ++g) gden += __expf(lg[g] - gmax);
            gsel[r] = gs; pg[r] = 1.f / gden;
        }
        float ce[NB];
#pragma unroll
        for (int r = 0; r < NB; ++r) {
            float sp[8];
            const float* wp0 = lwre + gsel[r] * 8 * 1024;
#pragma unroll
            for (int e = 0; e < 8; ++e) {
                float s_ = 0.f;
#pragma unroll
                for (int j = 0; j < 4; ++j) {
                    const float4 wv = *(const float4*)(wp0 + e * 1024 + (j * 64 + lane) * 4);
                    s_ += v[r][j].x * wv.x + v[r][j].y * wv.y + v[r][j].z * wv.z + v[r][j].w * wv.w;
                }
                sp[e] = s_;
            }
            float a[4];
#pragma unroll
            for (int i = 0; i < 4; ++i) a[i] = (h5 ? sp[4 + i] : sp[i]) + __shfl_xor(h5 ? sp[i] : sp[4 + i], 32);
            const float b0 = (h4 ? a[2] : a[0]) + __shfl_xor(h4 ? a[0] : a[2], 16);
            const float b1 = (h4 ? a[3] : a[1]) + __shfl_xor(h4 ? a[1] : a[3], 16);
            float c = (h3 ? b1 : b0) + dpp_f<0x140>(h3 ? b0 : b1);
            c += dpp_f<0xB1>(c); c += dpp_f<0x4E>(c); c += dpp_f<0x141>(c);
            ce[r] = c;
        }
#pragma unroll
        for (int r = 0; r < NB; ++r) {
            float le[8];
#pragma unroll
            for (int e = 0; e < 8; ++e) le[e] = rl(ce[r], (e >> 2) * 32 + ((e >> 1) & 1) * 16 + (e & 1) * 8) + p.b_re[gsel[r] * 8 + e];
            int e1 = 0; float l1 = le[0];
#pragma unroll
            for (int e = 1; e < 8; ++e) if (le[e] > l1) { l1 = le[e]; e1 = e; }
            int e2 = -1; float l2 = -3.0e38f;
#pragma unroll
            for (int e = 0; e < 8; ++e) if (e != e1 && le[e] > l2) { l2 = le[e]; e2 = e; }
            const float ex = __expf(l2 - l1);
            const float c1 = pg[r] / (1.f + ex), c2 = pg[r] * ex / (1.f + ex);
            if (lane == 0) {
                const int tl = tl0 + r;
                const int E1 = gsel[r] * 8 + e1, E2 = gsel[r] * 8 + e2;
                recE[tl * 2] = E1; recE[tl * 2 + 1] = E2;
                recP[tl * 2] = atomicAdd(&lcnt[E1], 1); recP[tl * 2 + 1] = atomicAdd(&lcnt[E2], 1);
                recC[tl * 2] = c1; recC[tl * 2 + 1] = c2;
            }
        }
    }
    __syncthreads();
    if (threadIdx.x < 32) { const int n = lcnt[threadIdx.x]; lbase[threadIdx.x] = n ? atomicAdd(&cnt[threadIdx.x * 64], n) : 0; }
    __syncthreads();
    if (threadIdx.x < 64) {
        const int tl = threadIdx.x, row = tb * 64 + tl;
        const int E1 = recE[tl * 2], E2 = recE[tl * 2 + 1];
        const int p1 = lbase[E1] + recP[tl * 2], p2 = lbase[E2] + recP[tl * 2 + 1];
        list[E1 * CAP + p1] = row; cw[E1 * CAP + p1] = recC[tl * 2];
        list[E2 * CAP + p2] = row; cw[E2 * CAP + p2] = recC[tl * 2 + 1];
        tinfo[row] = make_int4(E1, p1, E2, p2);
    }
    }
}

DI void build_offsets(const Params& p, int* loff, int* ltoff) {
    const int* cnt = (const int*)(p.ws + WS_CNT);
    int* lc = ltoff + 40;
    __syncthreads();
    if (threadIdx.x < NE) lc[threadIdx.x] = cnt[threadIdx.x * 64];
    __syncthreads();
    if (threadIdx.x == 0) {
        int o = 0, to = 0;
        for (int e = 0; e < NE; ++e) { loff[e] = o; ltoff[e] = to; const int c = lc[e]; o += c; to += (c + 255) >> 8; }
        loff[NE] = o; ltoff[NE] = to;
    }
    __syncthreads();
}

struct MoeSched {
    const char* A; const char* W; size_t wstride; int K, mode;
    const int* cnt; const int* list; const int* loff; const int* ltoff;
    int G, c, nunits;
    DI bool next(int i, pg::Unit& u, const int (&R)[2], const int (&C)[2]) const {
        int e, tl, pn;
        if (G == 256) {
            int j = i * 32 + (c >> 3), q = 0;
            e = c & 7;
            for (; q < 4; ++q) {
                const int nu = __builtin_amdgcn_readfirstlane((ltoff[e + 1] - ltoff[e]) * 4);
                if (j < nu) break;
                j -= nu; e += 8;
            }
            if (q == 4) return false;
            tl = j >> 2; pn = j & 3;
        } else {
            const int Lx = i * G + c; if (Lx >= nunits) return false;
            const int gt = Lx >> 2; pn = Lx & 3;
            e = 0;
            while (e < NE - 1 && ltoff[e + 1] <= gt) ++e;
            tl = gt - ltoff[e];
        }
        u.e = e; u.tl = tl; u.cnt = cnt[e * 64]; u.pm = u.tl; u.pn = pn;
        u.A = A; u.B = W + (size_t)e * wstride + (size_t)pn * 256 * K * 2;
#pragma unroll
        for (int h = 0; h < 2; ++h)
#pragma unroll
            for (int j = 0; j < 2; ++j) {
                int idx = u.tl * 256 + h * 128 + R[j];
                if (idx >= u.cnt) idx = u.cnt - 1;
                const int row = (mode == 0) ? list[e * CAP + idx] : (loff[e] + idx);
                u.ao[h][j] = (unsigned)(row * K + C[j]) * 2u;
            }
        return true;
    }
};

struct EpiP7 {
    static constexpr bool PERM = true;
    unsigned char* ws; const int* loff;
    template <bool CHECK>
    DI void body(const f32x4 (&acc)[2][2][4][2], const pg::Unit& u, int wr, int wc, int fr, int fq) const {
        const int idx0 = u.tl * 256 + wr * 64 + fr;
        const float* cw = (const float*)(ws + WS_CW) + (size_t)u.e * CAP + idx0;
        u16* ACT = (u16*)(ws + WS_ACT) + (size_t)(loff[u.e] + idx0) * DE + u.pn * 128 + wc * 32 + 8 * fq;
        float cwv[2][4];
#pragma unroll
        for (int ai = 0; ai < 2; ++ai)
#pragma unroll
            for (int m = 0; m < 4; ++m) cwv[ai][m] = (!CHECK || idx0 + ai * 128 + m * 16 < u.cnt) ? cw[ai * 128 + m * 16] : 0.f;
#pragma unroll
        for (int ai = 0; ai < 2; ++ai)
#pragma unroll
            for (int m = 0; m < 4; ++m) {
                f32x4 o0, o1;
#pragma unroll
                for (int j = 0; j < 4; ++j) {
                    o0[j] = siluf_(acc[ai][0][m][0][j]) * acc[ai][1][m][0][j] * cwv[ai][m];
                    o1[j] = siluf_(acc[ai][0][m][1][j]) * acc[ai][1][m][1][j] * cwv[ai][m];
                }
                if (!CHECK || idx0 + ai * 128 + m * 16 < u.cnt) *(u32x4*)(ACT + (size_t)(ai * 128 + m * 16) * DE) = pack8v(o0, o1);
            }
    }
    DI void operator()(const f32x4 (&acc)[2][2][4][2], const pg::Unit& u, int wr, int wc, int fr, int fq) const {
        if (u.tl * 256 + 256 <= u.cnt) body<false>(acc, u, wr, wc, fr, fq);
        else body<true>(acc, u, wr, wc, fr, fq);
    }
};

DI void phase7(const Params& p, char* lds) {
    int* loff = (int*)(lds + pg::STAGE_BYTES); int* ltoff = loff + 40;
    build_offsets(p, loff, ltoff);
    MoeSched S; S.A = (const char*)(p.ws + WS_HM2); S.W = (const char*)(p.ws + WS_WGU); S.wstride = (size_t)1024 * D * 2; S.K = D; S.mode = 0;
    S.cnt = (const int*)(p.ws + WS_CNT); S.list = (const int*)(p.ws + WS_LIST); S.loff = loff; S.ltoff = ltoff;
    S.G = gridDim.x; S.c = blockIdx.x; S.nunits = ltoff[NE] * 4;
    EpiP7 E{p.ws, loff};
    pg::gemm_phase((LAS unsigned char*)lds, D, S, E);
    {
        int* qhead = (int*)(p.ws + WS_CNT) + 32 * 64;
        int* lq = ltoff + 80;
        float* lt = (float*)lds; float* lt0 = lt; float* lt1 = lt + 2 * 64 * 65;
        for (;;) {
            __syncthreads();
            if (threadIdx.x == 0) lq[0] = atomicAdd(qhead, 2);
            __syncthreads();
            const int q = lq[0];
            if (q >= TP_DN) break;
            const TpDesc da = tp_decode(p, TP_TOTAL - TP_DN + q), db = tp_decode(p, TP_TOTAL - TP_DN + q + 1);
            f32x4 ra[4], rb[4];
            tp_load(da, ra); tp_load(db, rb);
            tp_to_lds(lt0, ra); tp_to_lds(lt1, rb);
            __syncthreads();
            tp_store(lt0, da); tp_store(lt1, db);
        }
    }
}

struct EpiP8 {
    static constexpr bool PERM = true;
    unsigned char* ws; const int* loff;
    template <bool CHECK>
    DI void body(const f32x4 (&acc)[2][2][4][2], const pg::Unit& u, int wr, int wc, int fr, int fq) const {
        const int idx0 = u.tl * 256 + wr * 64 + fr;
        u16* rowp = (u16*)(ws + WS_OUTP) + (size_t)(loff[u.e] + idx0) * D + u.pn * 256 + wc * 32 + 8 * fq;
#pragma unroll
        for (int ai = 0; ai < 2; ++ai)
#pragma unroll
            for (int m = 0; m < 4; ++m)
                if (!CHECK || idx0 + ai * 128 + m * 16 < u.cnt) {
#pragma unroll
                    for (int bj = 0; bj < 2; ++bj) *(u32x4*)(rowp + (size_t)(ai * 128 + m * 16) * D + bj * 128) = pack8v(acc[ai][bj][m][0], acc[ai][bj][m][1]);
                }
    }
    DI void operator()(const f32x4 (&acc)[2][2][4][2], const pg::Unit& u, int wr, int wc, int fr, int fq) const {
        if (u.tl * 256 + 256 <= u.cnt) body<false>(acc, u, wr, wc, fr, fq);
        else body<true>(acc, u, wr, wc, fr, fq);
    }
};

DI void phase8(const Params& p, char* lds) {
    int* loff = (int*)(lds + pg::STAGE_BYTES); int* ltoff = loff + 40;
    build_offsets(p, loff, ltoff);
    MoeSched S; S.A = (const char*)(p.ws + WS_ACT); S.W = (const char*)(p.ws + WS_WDN); S.wstride = (size_t)D * DE * 2; S.K = DE; S.mode = 1;
    S.cnt = (const int*)(p.ws + WS_CNT); S.list = (const int*)(p.ws + WS_LIST); S.loff = loff; S.ltoff = ltoff;
    S.G = gridDim.x; S.c = blockIdx.x; S.nunits = ltoff[NE] * 4;
    EpiP8 E{p.ws, loff};
    pg::gemm_phase((LAS unsigned char*)lds, DE, S, E);
}

DI void phase9(const Params& p, char* lds) {
    float* lm = (float*)lds;
    int* loff = (int*)(lds + 4096); int* ltoff = loff + 40;
    load_modvec(lm, p, 0, 5);
    build_offsets(p, loff, ltoff);
    const int lane = threadIdx.x & 63, w = threadIdx.x >> 6;
    const float* H1 = (const float*)(p.ws + WS_Y);
    const u16* OUTP = (const u16*)(p.ws + WS_OUTP);
    const int4* tinfo = (const int4*)(p.ws + WS_TINFO);
    for (int row0 = (blockIdx.x * NWV + w) * 4; row0 < L; row0 += gridDim.x * NWV * 4) {
        float4 v[4][4];
#pragma unroll
        for (int r = 0; r < 4; ++r) {
            const int row = row0 + r;
            const int4 ti = tinfo[row];
            const u16* r1 = OUTP + (size_t)(loff[ti.x] + ti.y) * D;
            const u16* r2 = OUTP + (size_t)(loff[ti.z] + ti.w) * D;
#pragma unroll
            for (int j = 0; j < 4; ++j) {
                const int e = (j * 64 + lane) * 4;
                const f32x4 hv = __builtin_nontemporal_load((const f32x4*)(H1 + (size_t)row * D + e));
                const float4 h = make_float4(hv[0], hv[1], hv[2], hv[3]);
                const u32x2 av = __builtin_nontemporal_load((const u32x2*)(r1 + e)), bv2 = __builtin_nontemporal_load((const u32x2*)(r2 + e));
                const uint2 a = make_uint2(av[0], av[1]), b = make_uint2(bv2[0], bv2[1]);
                const float4 g2 = *(const float4*)(lm + e);
                v[r][j].x = ALPHA * h.x + g2.x * (bflo(a.x) + bflo(b.x));
                v[r][j].y = ALPHA * h.y + g2.y * (bfhi(a.x) + bfhi(b.x));
                v[r][j].z = ALPHA * h.z + g2.z * (bflo(a.y) + bflo(b.y));
                v[r][j].w = ALPHA * h.w + g2.w * (bfhi(a.y) + bfhi(b.y));
            }
        }
        ln_rows<4>(v, p.ln2_g, p.ln2_b, lane);
#pragma unroll
        for (int r = 0; r < 4; ++r)
#pragma unroll
            for (int j = 0; j < 4; ++j) { const f32x4 ov = {v[r][j].x, v[r][j].y, v[r][j].z, v[r][j].w}; __builtin_nontemporal_store(ov, (f32x4*)(p.out + (size_t)(row0 + r) * D + (j * 64 + lane) * 4)); }
    }
}

#define XB_TMO      128
#define XB_XCNT(j)  (256  + 64 * (j))
#define XB_XSUB(j)  (1280 + 64 * (j))
#define XB_XGEN(j)  (2304 + 64 * (j))
#define XB_TOP      3328
#define XB_TOPGEN   3392
#define XCD_BAR_WORDS 3456
#define XB_SPIN_CAP (1u << 18)
DI unsigned xb_ld(unsigned* p)              { return __hip_atomic_load(p, __ATOMIC_RELAXED, __HIP_MEMORY_SCOPE_AGENT); }
DI unsigned xb_add(unsigned* p, unsigned v) { return __hip_atomic_fetch_add(p, v, __ATOMIC_RELAXED, __HIP_MEMORY_SCOPE_AGENT); }
DI unsigned xb_xcc_id() { return (unsigned)__builtin_amdgcn_s_getreg((3 << 11) | 20) & 0xFu; }
#define XB_SPIN(cond, bar) do { unsigned _sp = 0; while (cond) { __builtin_amdgcn_s_sleep(1); \
    if ((++_sp & 255u) == 0u) { if (xb_ld(&(bar)[XB_TMO])) break; if (_sp > XB_SPIN_CAP) { atomicAdd(&(bar)[XB_TMO], 1u); break; } } } } while (0)
struct XcdBarrier { unsigned* bar; unsigned x; volatile LAS unsigned* st; };
DI XcdBarrier xcd_barrier_post(unsigned* bar, volatile LAS unsigned* st) {
    XcdBarrier b; b.bar = bar; b.x = xb_xcc_id(); b.st = st;
    if (threadIdx.x == 0) (void)xb_add(&bar[XB_XCNT(b.x)], 1u);
    return b;
}
DI void xcd_barrier_complete(unsigned* bar, unsigned x, unsigned& nloc, unsigned& nx) {
    const unsigned G = gridDim.x * gridDim.y * gridDim.z;
    unsigned sum, cnt, mine, sp = 0u;
    for (;;) {
        sum = 0u; cnt = 0u; mine = 0u;
#pragma unroll
        for (unsigned j = 0; j < 16; ++j) { const unsigned c = xb_ld(&bar[XB_XCNT(j)]); sum += c; cnt += (c > 0u) ? 1u : 0u; mine = (j == x) ? c : mine; }
        if (sum == G) break;
        __builtin_amdgcn_s_sleep(1);
        if ((++sp & 255u) == 0u) { if (xb_ld(&bar[XB_TMO])) break; if (sp > XB_SPIN_CAP) { atomicAdd(&bar[XB_TMO], 1u); break; } }
    }
    nloc = mine > 0u ? mine : 1u; nx = cnt > 0u ? cnt : 1u;
}
DI void xcd_barrier(const XcdBarrier& b) {
    asm volatile("s_waitcnt vmcnt(0)" ::: "memory");
    __syncthreads();
    if (threadIdx.x == 0) {
        unsigned* bar = b.bar;
        __builtin_amdgcn_s_waitcnt(0);
        unsigned nloc = b.st[0], nx = b.st[1];
        if (nloc == 0u) { xcd_barrier_complete(bar, b.x, nloc, nx); b.st[0] = nloc; b.st[1] = nx; }
        const unsigned old = xb_add(&bar[XB_XSUB(b.x)], 1u);
        const unsigned gen = old / nloc;
        if (old + 1u == (gen + 1u) * nloc) {
            __builtin_amdgcn_fence(__ATOMIC_RELEASE, "agent");
            asm volatile("s_waitcnt vmcnt(0)" ::: "memory");
            const unsigned og = xb_add(&bar[XB_TOP], 1u);
            const unsigned tg = og / nx;
            if (og + 1u == (tg + 1u) * nx) xb_add(&bar[XB_TOPGEN], 1u);
            else XB_SPIN(xb_ld(&bar[XB_TOPGEN]) == tg, bar);
            __builtin_amdgcn_fence(__ATOMIC_ACQUIRE, "agent");
            xb_add(&bar[XB_XGEN(b.x)], 1u);
            asm volatile("s_waitcnt vmcnt(0)" ::: "memory");
        } else {
            XB_SPIN(xb_ld(&bar[XB_XGEN(b.x)]) == gen, bar);
            __builtin_amdgcn_fence(__ATOMIC_ACQUIRE, "agent");
            asm volatile("s_waitcnt vmcnt(0)" ::: "memory");
        }
    }
    __syncthreads();
}

extern __shared__ __attribute__((aligned(16))) char dyn_lds[];
constexpr int LDS_TOTAL = 152576;

__global__ void __launch_bounds__(512, 2) fwd_mega(Params p) {
    cg::grid_group grid = cg::this_grid();
    char* lds = dyn_lds;
    __shared__ uint4 xb_words;
    if (threadIdx.x == 0) xb_words = make_uint4(0u, 0u, 0u, 0u);
    __syncthreads();
    XcdBarrier xb = xcd_barrier_post((unsigned*)(p.ws + WS_BAR), (volatile LAS unsigned*)&xb_words);
    if (p.ph_hi > 1000) grid.sync();
#ifndef DUP_MASK
#define DUP_MASK 0
#endif
#define RUN_PHASE(n) if (p.ph_lo <= n && n < p.ph_hi) { phase##n(p, lds); if ((DUP_MASK >> n) & 1) { xcd_barrier(xb); phase##n(p, lds); } if (n + 1 < p.ph_hi) xcd_barrier(xb); }
    if (p.ph_lo <= 0 && 0 < p.ph_hi) { phase0(p, lds); if (p.ph_hi == 1) {} }
    RUN_PHASE(1) RUN_PHASE(2) RUN_PHASE(3) RUN_PHASE(4)
    RUN_PHASE(5) RUN_PHASE(6) RUN_PHASE(7) RUN_PHASE(8) RUN_PHASE(9)
#undef RUN_PHASE
}

extern "C" void kernel_launch(void* const* d_in, const int* in_sizes, int n_in, void* d_out, int out_size, void* d_ws, size_t ws_size, hipStream_t stream) {
    static int grid_blocks = 0;
    if (!grid_blocks) {
        int dev = 0, cus = 0, per_cu = 0;
        hipGetDevice(&dev);
        hipDeviceGetAttribute(&cus, hipDeviceAttributeMultiprocessorCount, dev);
        hipFuncSetAttribute((const void*)fwd_mega, hipFuncAttributeMaxDynamicSharedMemorySize, LDS_TOTAL);
        hipOccupancyMaxActiveBlocksPerMultiprocessor(&per_cu, (const void*)fwd_mega, NTH, LDS_TOTAL);
        if (per_cu < 1) per_cu = 1;
        if (per_cu > 1) per_cu = 1;
        grid_blocks = cus * per_cu;
        if (ws_size < WS_END) fprintf(stderr, "kernel_launch: workspace too small: %zu < %zu\n", ws_size, (size_t)WS_END);
    }
    Params p{};
    const float** pf = (const float**)&p;
    for (int i = 0; i < 26; ++i) pf[i] = (const float*)d_in[i];
    p.out = (float*)d_out;
    p.ws = (unsigned char*)d_ws;
#if N_LAUNCH_MODE == 1
    (void)hipMemsetAsync((char*)d_ws + WS_BAR, 0, XCD_BAR_WORDS * 4, stream);
    p.ph_lo = 0; p.ph_hi = NPHASE;
    void* args[] = {&p};
    hipError_t e = hipLaunchCooperativeKernel((const void*)fwd_mega, dim3(grid_blocks), dim3(NTH), args, LDS_TOTAL, stream);
    if (e != hipSuccess) fprintf(stderr, "cooperative launch failed: %s (grid %d)\n", hipGetErrorString(e), grid_blocks);
#else
    for (int ph = 0; ph < NPHASE; ++ph) {
        p.ph_lo = ph; p.ph_hi = ph + 1;
        hipLaunchKernelGGL(fwd_mega, dim3(grid_blocks), dim3(NTH), LDS_TOTAL, stream, p);
#ifdef PROBE_DUP
        if (ph == PROBE_DUP) hipLaunchKernelGGL(fwd_mega, dim3(grid_blocks), dim3(NTH), LDS_TOTAL, stream, p);
#endif
    }
#endif
}
```
